# Optimizing an MI355X kernel written in HIP

```python
import math
import jax, jax.numpy as jnp
from jax import lax
import numpy as np

D_MODEL = 1024
BATCH = 4
SEQ = 4096
DEPTH = 4

MIX_WIDTH = D_MODEL
BRANCH = MIX_WIDTH // 4
CONF_KERNEL = 31
S5_GROUP = 16
S5_GROUPS = BRANCH // S5_GROUP
S5_STATE = 64
SC_KERNEL = 3
DN_HEADS = 4
DN_HEAD_DIM = BRANCH // DN_HEADS
DN_CONV = 4
DN_CHUNK = 64
NORM_EPS = 1e-6
IN_WIDTHS = (BRANCH, BRANCH, BRANCH,
             BRANCH, BRANCH,
             BRANCH, BRANCH, BRANCH, BRANCH,
             BRANCH, BRANCH, BRANCH, DN_HEADS, DN_HEADS, BRANCH)
IN_COLS = 13 * BRANCH + 2 * DN_HEADS

kernel_name = "hybrid_parallel_conv_s5_shortconv_deltanet"


def rms_norm(x, g):
    x32 = x.astype(jnp.float32)
    y = x32 * lax.rsqrt(jnp.mean(x32 * x32, axis=-1, keepdims=True) + NORM_EPS)
    return (y * g.astype(jnp.float32)).astype(x.dtype)


def layer_norm(x, g, b):
    x32 = x.astype(jnp.float32)
    mu = jnp.mean(x32, axis=-1, keepdims=True)
    xc = x32 - mu
    y = xc * lax.rsqrt(jnp.mean(xc * xc, axis=-1, keepdims=True) + NORM_EPS)
    return (y * g.astype(jnp.float32) + b.astype(jnp.float32)).astype(x.dtype)


def l2_normalize(x):
    return x * lax.rsqrt(jnp.sum(x * x, axis=-1, keepdims=True) + NORM_EPS)


def causal_depthwise_conv(x, w):
    K, C = w.shape
    return lax.conv_general_dilated(
        x, w[:, None, :], window_strides=(1,), padding=[(K - 1, 0)],
        dimension_numbers=("NWC", "WIO", "NWC"), feature_group_count=C)


def split_columns(p):
    outs, start = [], 0
    for w in IN_WIDTHS:
        outs.append(p[..., start:start + w])
        start += w
    return outs


def conformer_conv_branch(val, gate, conv_w, conv_b, ln_g, ln_b, pw_w, pw_b):
    a = val * jax.nn.sigmoid(gate)
    a = causal_depthwise_conv(a, conv_w) + conv_b
    a = layer_norm(a, ln_g, ln_b)
    a = jax.nn.silu(a)
    return a @ pw_w + pw_b


def s5_branch(u, lam_re, lam_im, b_re, b_im, c_re, c_im, d_skip, log_dt, glu_w, glu_b):
    bsz, L, _ = u.shape
    f32 = jnp.float32
    u32 = u.astype(f32)
    lam = lax.complex(jnp.minimum(lam_re.astype(f32), -1e-4), lam_im.astype(f32))
    dt = jnp.exp(log_dt.astype(f32))[:, None]
    lam_bar = jnp.exp(lam * dt)
    b = lax.complex(b_re.astype(f32), b_im.astype(f32))
    b_bar = ((lam_bar - 1.0) / lam)[..., None] * b
    ug = u32.reshape(bsz, L, S5_GROUPS, S5_GROUP).astype(jnp.complex64)
    bu = jnp.einsum("blgh,gph->blgp", ug, b_bar)
    a = jnp.broadcast_to(lam_bar, bu.shape)

    def combine(e1, e2):
        a1, s1 = e1
        a2, s2 = e2
        return a1 * a2, a2 * s1 + s2

    _, states = lax.associative_scan(combine, (a, bu), axis=1)
    c = lax.complex(c_re.astype(f32), c_im.astype(f32))
    y = jnp.real(jnp.einsum("blgp,ghp->blgh", states, c)).reshape(bsz, L, BRANCH)
    y = y + d_skip.astype(f32) * u32
    y = jax.nn.gelu(y).astype(u.dtype)
    return y * jax.nn.sigmoid(y @ glu_w + glu_b)


def short_conv_branch(bg, cg, xc, conv_w):
    return bg * causal_depthwise_conv(cg * xc, conv_w)


def gated_delta_rule_chunked(q, k, v, beta, g):
    bsz, L, H, dk = q.shape
    dv = v.shape[-1]
    C = DN_CHUNK
    N = L // C

    def chunk(t):
        t = t.reshape(bsz, N, C, H, t.shape[-1])
        return jnp.transpose(t, (1, 0, 3, 2, 4))

    q, k, v = chunk(q), chunk(k), chunk(v)
    beta = chunk(beta[..., None])[..., 0]
    g = chunk(g[..., None])[..., 0]
    gc = jnp.cumsum(g, axis=-1)
    idx = jnp.arange(C)
    causal = idx[:, None] >= idx[None, :]
    strict = idx[:, None] > idx[None, :]
    decay = jnp.exp(jnp.where(causal, gc[..., :, None] - gc[..., None, :], -jnp.inf))
    k_beta = k * beta[..., None]
    lmat = jnp.where(strict, jnp.einsum("nbhid,nbhjd->nbhij", k_beta, k) * decay, 0.0)
    rhs = jnp.concatenate([v * beta[..., None], k_beta * jnp.exp(gc)[..., None]], axis=-1)
    sol = lax.linalg.triangular_solve(lmat + jnp.eye(C, dtype=lmat.dtype), rhs,
                                      left_side=True, lower=True)
    u, w = sol[..., :dv], sol[..., dv:]
    attn = jnp.einsum("nbhid,nbhjd->nbhij", q, k) * decay
    q_dec = q * jnp.exp(gc)[..., None]
    g_last = gc[..., -1]
    k_dec = k * jnp.exp(g_last[..., None] - gc)[..., None]

    def step(S, inp):
        attn_c, u_c, w_c, qd, kd, gl = inp
        v_new = u_c - jnp.einsum("bhik,bhkv->bhiv", w_c, S)
        o = jnp.einsum("bhik,bhkv->bhiv", qd, S) + jnp.einsum("bhij,bhjv->bhiv", attn_c, v_new)
        S = S * jnp.exp(gl)[..., None, None] + jnp.einsum("bhik,bhiv->bhkv", kd, v_new)
        return S, o

    S0 = jnp.zeros((bsz, H, dk, dv), jnp.float32)
    _, o = lax.scan(step, S0, (attn, u, w, q_dec, k_dec, g_last))
    return jnp.transpose(o, (1, 0, 3, 2, 4)).reshape(bsz, L, H, dv)


def deltanet_branch(q, k, v, alpha, beta_logit, conv_w, a_log, dt_bias, norm_g):
    bsz, L, _ = q.shape
    f32 = jnp.float32
    qkv = jax.nn.silu(causal_depthwise_conv(jnp.concatenate([q, k, v], axis=-1), conv_w))
    q, k, v = qkv[..., :BRANCH], qkv[..., BRANCH:2 * BRANCH], qkv[..., 2 * BRANCH:]
    q = q.astype(f32).reshape(bsz, L, DN_HEADS, DN_HEAD_DIM)
    k = k.astype(f32).reshape(bsz, L, DN_HEADS, DN_HEAD_DIM)
    v = v.astype(f32).reshape(bsz, L, DN_HEADS, DN_HEAD_DIM)
    q = l2_normalize(q) * (DN_HEAD_DIM ** -0.5)
    k = l2_normalize(k)
    beta = jax.nn.sigmoid(beta_logit.astype(f32))
    g = -jnp.exp(a_log.astype(f32)) * jax.nn.softplus(alpha.astype(f32) + dt_bias.astype(f32))
    o = gated_delta_rule_chunked(q, k, v, beta, g)
    o = rms_norm(o, norm_g)
    return o.reshape(bsz, L, BRANCH)


def setup_inputs(seed: int = 0) -> dict:
    key = jax.random.key(seed)
    ks = jax.random.split(key, 32)
    f32 = jnp.float32

    def nrm(k, shape, s):
        return jax.random.normal(k, shape, f32) * s

    G, P, H = S5_GROUPS, S5_STATE, S5_GROUP
    x = nrm(ks[0], (BATCH, SEQ, D_MODEL), 1.0)
    norm_g = 1.0 + nrm(ks[1], (DEPTH, D_MODEL), 0.02)
    w_in = nrm(ks[2], (DEPTH, D_MODEL, IN_COLS), D_MODEL ** -0.5)
    a_conv_w = nrm(ks[3], (DEPTH, CONF_KERNEL, BRANCH), CONF_KERNEL ** -0.5)
    a_conv_b = nrm(ks[4], (DEPTH, BRANCH), 0.02)
    a_ln_g = 1.0 + nrm(ks[5], (DEPTH, BRANCH), 0.02)
    a_ln_b = nrm(ks[6], (DEPTH, BRANCH), 0.02)
    a_pw_w = nrm(ks[7], (DEPTH, BRANCH, BRANCH), BRANCH ** -0.5)
    a_pw_b = nrm(ks[8], (DEPTH, BRANCH), 0.02)
    n_idx = jnp.arange(P, dtype=f32)
    s5_lambda_re = -0.5 + nrm(ks[9], (DEPTH, G, P), 0.01)
    s5_lambda_im = math.pi * n_idx + nrm(ks[10], (DEPTH, G, P), 0.01)
    s5_b_re = nrm(ks[11], (DEPTH, G, P, H), (2.0 * H) ** -0.5)
    s5_b_im = nrm(ks[12], (DEPTH, G, P, H), (2.0 * H) ** -0.5)
    s5_c_re = nrm(ks[13], (DEPTH, G, H, P), (2.0 * P) ** -0.5)
    s5_c_im = nrm(ks[14], (DEPTH, G, H, P), (2.0 * P) ** -0.5)
    s5_d = nrm(ks[15], (DEPTH, BRANCH), 0.5)
    s5_log_dt = jax.random.uniform(ks[16], (DEPTH, G), f32, math.log(1e-3), math.log(1e-1))
    s5_glu_w = nrm(ks[17], (DEPTH, BRANCH, BRANCH), BRANCH ** -0.5)
    s5_glu_b = nrm(ks[18], (DEPTH, BRANCH), 0.02)
    c_conv_w = nrm(ks[19], (DEPTH, SC_KERNEL, BRANCH), SC_KERNEL ** -0.5)
    d_conv_w = nrm(ks[20], (DEPTH, DN_CONV, 3 * BRANCH), DN_CONV ** -0.5)
    d_a_log = jnp.log(jax.random.uniform(ks[21], (DEPTH, DN_HEADS), f32, 1.0, 16.0))
    dt0 = jnp.exp(jax.random.uniform(ks[22], (DEPTH, DN_HEADS), f32, math.log(1e-3), math.log(1e-1)))
    d_dt_bias = dt0 + jnp.log(-jnp.expm1(-dt0))
    d_norm_g = 1.0 + nrm(ks[23], (DEPTH, DN_HEAD_DIM), 0.02)
    w_out = nrm(ks[24], (DEPTH, MIX_WIDTH, D_MODEL), MIX_WIDTH ** -0.5)
    final_g = 1.0 + nrm(ks[25], (D_MODEL,), 0.02)
    return {"x": x, "norm_g": norm_g, "w_in": w_in,
            "a_conv_w": a_conv_w, "a_conv_b": a_conv_b, "a_ln_g": a_ln_g, "a_ln_b": a_ln_b,
            "a_pw_w": a_pw_w, "a_pw_b": a_pw_b,
            "s5_lambda_re": s5_lambda_re, "s5_lambda_im": s5_lambda_im,
            "s5_b_re": s5_b_re, "s5_b_im": s5_b_im, "s5_c_re": s5_c_re, "s5_c_im": s5_c_im,
            "s5_d": s5_d, "s5_log_dt": s5_log_dt, "s5_glu_w": s5_glu_w, "s5_glu_b": s5_glu_b,
            "c_conv_w": c_conv_w,
            "d_conv_w": d_conv_w, "d_a_log": d_a_log, "d_dt_bias": d_dt_bias, "d_norm_g": d_norm_g,
            "w_out": w_out, "final_g": final_g}


def reference(x, norm_g, w_in, a_conv_w, a_conv_b, a_ln_g, a_ln_b, a_pw_w, a_pw_b,
              s5_lambda_re, s5_lambda_im, s5_b_re, s5_b_im, s5_c_re, s5_c_im,
              s5_d, s5_log_dt, s5_glu_w, s5_glu_b, c_conv_w,
              d_conv_w, d_a_log, d_dt_bias, d_norm_g, w_out, final_g):
    for l in range(DEPTH):
        h = rms_norm(x, norm_g[l])
        proj = h @ w_in[l]
        (a_val, a_gate, a_z, b_u, b_z, c_b, c_c, c_x, c_z,
         d_q, d_k, d_v, d_alpha, d_beta, d_z) = split_columns(proj)
        ya = conformer_conv_branch(a_val, a_gate, a_conv_w[l], a_conv_b[l], a_ln_g[l],
                                   a_ln_b[l], a_pw_w[l], a_pw_b[l]) * jax.nn.silu(a_z)
        yb = s5_branch(b_u, s5_lambda_re[l], s5_lambda_im[l], s5_b_re[l], s5_b_im[l],
                       s5_c_re[l], s5_c_im[l], s5_d[l], s5_log_dt[l],
                       s5_glu_w[l], s5_glu_b[l]) * jax.nn.silu(b_z)
        yc = short_conv_branch(c_b, c_c, c_x, c_conv_w[l]) * jax.nn.silu(c_z)
        yd = deltanet_branch(d_q, d_k, d_v, d_alpha, d_beta, d_conv_w[l], d_a_log[l],
                             d_dt_bias[l], d_norm_g[l]).astype(x.dtype) * jax.nn.silu(d_z)
        mixed = jnp.concatenate([ya, yb.astype(x.dtype), yc, yd], axis=-1)
        x = x + mixed @ w_out[l]
    return rms_norm(x, final_g)
```

```cpp
#include <hip/hip_runtime.h>
#include <cstdio>
#include <cstdint>
namespace pg8 {
#define PG8_LAS __attribute__((address_space(3)))
typedef unsigned short bf16_t;
typedef short bf16x8 __attribute__((ext_vector_type(8)));
typedef float f32x4 __attribute__((ext_vector_type(4)));
typedef unsigned u32x4 __attribute__((ext_vector_type(4)));
constexpr int BM = 256, BK = 64, HALF = 128, HTB = HALF * BK * 2  , STAGE_BYTES = 8 * HTB, NXCD = 8, WGM = 8;

__host__ __device__ __forceinline__ int lds_byte(int r, int c) { const int st = (r >> 4) * 2 + (c >> 5), rr = r & 15, cc = c & 31, ob = rr * 64 + cc * 2; return st * 1024 + (ob ^ (((ob >> 9) & 1) << 5)); }
__host__ __device__ __forceinline__ void stage_rc(int b, int& R, int& C) { const int st = b / 1024, sb = b % 1024, swz = sb ^ (((sb >> 9) & 1) << 5); R = (st >> 1) * 16 + swz / 64; C = (st & 1) * 32 + (swz % 64) / 2; }
__host__ __device__ __forceinline__ int perm32(int rho) { const int n = rho >> 4, i = rho & 15; return 8 * (i >> 2) + 4 * n + (i & 3); }

struct Unit { int pm, pn; };
struct Gemm { const bf16_t* A; const bf16_t* Bt; int M, N, K; };

struct StaticOrder {
    int nM, nN, nwg, G, c;
    __host__ __device__ void init(int M, int N, int G_, int c_) { nM = M / BM; nN = N / BM; nwg = nM * nN; G = G_; c = c_; }
    __host__ __device__ bool next(int i, Unit& u) const {
        const long L = (long)i * G + c; if (L >= nwg) return false;
        int wgid = (int)L; { const int q = nwg / NXCD, r = nwg % NXCD, xcd = wgid % NXCD, off = wgid / NXCD; wgid = (xcd < r ? xcd * (q + 1) : r * (q + 1) + (xcd - r) * q) + off; }
        const int nig = WGM * nN, gid = wgid / nig, fm = gid * WGM, gsz = (nM - fm) < WGM ? (nM - fm) : WGM;
        u.pm = fm + ((wgid % nig) % gsz); u.pn = (wgid % nig) / gsz; return true;
    }
    __device__ __forceinline__ void a_ready(const Unit&) const {}
    __device__ __forceinline__ void done(const Unit&) const {}
};

__device__ __forceinline__ unsigned cvt_pk_bf16(float lo, float hi) { unsigned r; asm volatile("v_cvt_pk_bf16_f32 %0, %1, %2" : "=v"(r) : "v"(lo), "v"(hi)); return r; }
typedef unsigned u32x2 __attribute__((ext_vector_type(2)));

struct EpiInProj {
    static constexpr bool PERM = true, AFTER_DRAIN = false;
    bf16_t* P; const float* part; int cofs;
    __device__ __forceinline__ void operator()(const f32x4 (&acc)[2][2][4][2], const Unit& u, int wr, int wc, int fr, int fq) const {
        const int row0 = u.pm * BM + wr * 64 + fr;
        const int col0 = cofs + u.pn * BM + wc * 32 + 8 * fq;
#pragma unroll
        for (int ai = 0; ai < 2; ++ai)
#pragma unroll
            for (int m = 0; m < 4; ++m) {
                const int row = row0 + ai * HALF + m * 16;
                const f32x4* pp = (const f32x4*)(part + (size_t)row * 16);
                const f32x4 p0 = pp[0], p1 = pp[1], p2 = pp[2], p3 = pp[3];
                const float ss = ((p0[0] + p0[1]) + (p0[2] + p0[3])) + ((p1[0] + p1[1]) + (p1[2] + p1[3])) + ((p2[0] + p2[1]) + (p2[2] + p2[3])) + ((p3[0] + p3[1]) + (p3[2] + p3[3]));
                const float rstd = __builtin_amdgcn_rsqf(ss * (1.0f / 1024.0f) + 1e-6f);
                {
                    bf16_t* rowp = P + (size_t)row * 3328 + col0;
#pragma unroll
                    for (int bj = 0; bj < 2; ++bj) { const f32x4 v0 = acc[ai][bj][m][0] * rstd, v1 = acc[ai][bj][m][1] * rstd;
                        u32x4 w; w.x = cvt_pk_bf16(v0[0], v0[1]); w.y = cvt_pk_bf16(v0[2], v0[3]); w.z = cvt_pk_bf16(v1[0], v1[1]); w.w = cvt_pk_bf16(v1[2], v1[3]);
                        *(u32x4*)(rowp + bj * HALF) = w; }
                }
            }
    }
};

struct EpiOutProj {
    static constexpr bool PERM = false, AFTER_DRAIN = false;
    bf16_t* xb; bf16_t* xb2; float* part; int last;
    __device__ __forceinline__ void operator()(const f32x4 (&acc)[2][2][4][2], const Unit& u, int wr, int wc, int fr, int fq) const {
        const int row0 = u.pm * BM + wr * 64 + fr, col0 = u.pn * BM + wc * 32 + 4 * fq;
#pragma unroll
        for (int ai = 0; ai < 2; ++ai)
#pragma unroll
            for (int m = 0; m < 4; ++m) {
                const int row = row0 + ai * HALF + m * 16;
                float ss = 0.f;
#pragma unroll
                for (int bj = 0; bj < 2; ++bj)
#pragma unroll
                    for (int n = 0; n < 2; ++n) {
                        const size_t off = (size_t)row * 1024 + col0 + bj * HALF + n * 16;
                        const u32x2 xo = *(const u32x2*)(xb + off);
                        f32x4 v = acc[ai][bj][m][n];
                        v[0] += __builtin_bit_cast(float, xo.x << 16); v[1] += __builtin_bit_cast(float, xo.x & 0xffff0000u);
                        v[2] += __builtin_bit_cast(float, xo.y << 16); v[3] += __builtin_bit_cast(float, xo.y & 0xffff0000u);
                        ss += (v[0] * v[0] + v[1] * v[1]) + (v[2] * v[2] + v[3] * v[3]);
                        { u32x2 w; w.x = cvt_pk_bf16(v[0], v[1]); w.y = cvt_pk_bf16(v[2], v[3]); *(u32x2*)((last ? xb2 : xb) + off) = w; }
                    }
                ss += __shfl_xor(ss, 16); ss += __shfl_xor(ss, 32);
                if (fq == 0) part[(size_t)row * 16 + u.pn * 4 + wc] = ss;
            }
    }
};

template <class Epi, class Sched, bool ALIGN_EPI = false, bool SP2 = false>
__device__ __forceinline__ void gemm_phase(PG8_LAS unsigned char* lds, const Gemm g, const Sched& S, const Epi& E, int tid_in) {
    int tid_ = tid_in; asm volatile("" : "+v"(tid_));
    const int tid = tid_, wid = __builtin_amdgcn_readfirstlane(tid >> 6), lane = tid & 63, wr = wid >> 2, wc = wid & 3, fr = lane & 15, fq = lane >> 4;
    const int K = g.K, nt = K / BK;
    unsigned voffA[2], voffB[2];
#pragma unroll
    for (int i = 0; i < 2; ++i) { int R, C; stage_rc(tid * 16 + i * 8192, R, C); const int Rb = Epi::PERM ? ((R & ~31) + perm32(R & 31)) : R;
        voffA[i] = (unsigned)(R * K + C) * 2u; voffB[i] = (unsigned)(Rb * K + C) * 2u; }
    const size_t kstep = (size_t)(BK * 2);
    const size_t hstep = (size_t)HALF * K * 2;
    const size_t tstep = 2 * hstep;
    const unsigned ldsw = (unsigned)wid * 1024u;
    const int aoff = lds_byte(wr * 64 + fr, fq * 8), boff = lds_byte(wc * 32 + fr, fq * 8);
#define PG8_SA(b, h) (((b) * 2 + (h)) * HTB)
#define PG8_SB(b, h) ((4 + (b) * 2 + (h)) * HTB)
#define PG8_STAGE(bufoff, gbase, voff) do { _Pragma("unroll") for (int _i = 0; _i < 2; ++_i) \
        __builtin_amdgcn_global_load_lds((const unsigned*)((const char*)(gbase) + (voff)[_i]), (PG8_LAS unsigned*)(lds + (bufoff) + ldsw + _i * 8192), 16, 0, 0); } while (0)
#define PG8_LDA(dst, b, h) do { _Pragma("unroll") for (int m = 0; m < 4; ++m) _Pragma("unroll") for (int k = 0; k < 2; ++k) dst[m][k] = *(const PG8_LAS bf16x8*)(lds + PG8_SA(b, h) + aoff + m * 2048 + k * 1024); } while (0)
#define PG8_LDB(dst, b, h) do { _Pragma("unroll") for (int n = 0; n < 2; ++n) _Pragma("unroll") for (int k = 0; k < 2; ++k) dst[n][k] = *(const PG8_LAS bf16x8*)(lds + PG8_SB(b, h) + boff + n * 2048 + k * 1024); } while (0)
#define PG8_MMA(ai, bj, At, Bt) do { __builtin_amdgcn_s_setprio(1); _Pragma("unroll") for (int m = 0; m < 4; ++m) _Pragma("unroll") for (int n = 0; n < 2; ++n) _Pragma("unroll") for (int k = 0; k < 2; ++k) \
        acc[ai][bj][m][n] = __builtin_amdgcn_mfma_f32_16x16x32_bf16(Bt[n][k], At[m][k], acc[ai][bj][m][n], 0, 0, 0); __builtin_amdgcn_s_setprio(0); } while (0)
#define PG8_WAIT_V(n) asm volatile("s_waitcnt vmcnt(" #n ")" ::: "memory")
#define PG8_WAIT_L(n) asm volatile("s_waitcnt lgkmcnt(" #n ")" ::: "memory")
#define PG8_BAR __builtin_amdgcn_s_barrier()
#define PG8_SCHED __builtin_amdgcn_sched_barrier(0)
    Unit cur, nxt; int ui = 0;
    if (!S.next(0, cur)) return;
    f32x4 acc[2][2][4][2];
#pragma unroll
    for (int a = 0; a < 2; ++a)
#pragma unroll
        for (int b = 0; b < 2; ++b)
#pragma unroll
            for (int m = 0; m < 4; ++m)
#pragma unroll
                for (int n = 0; n < 2; ++n) acc[a][b][m][n] = (f32x4){0.f, 0.f, 0.f, 0.f};
    bf16x8 At[4][2], B0[2][2], B1[2][2];
    const char* cA = (const char*)g.A + (size_t)cur.pm * tstep; const char* cB = (const char*)g.Bt + (size_t)cur.pn * tstep;
    S.a_ready(cur);
    if constexpr (SP2) {
        PG8_STAGE(PG8_SB(0, 0), cB, voffB); PG8_STAGE(PG8_SB(0, 1), cB + hstep, voffB); PG8_STAGE(PG8_SA(0, 0), cA, voffA); PG8_STAGE(PG8_SA(0, 1), cA + hstep, voffA);
        if (wr == 1) PG8_BAR;
        PG8_WAIT_V(2); PG8_BAR;
        PG8_STAGE(PG8_SB(1, 0), cB + kstep, voffB); PG8_STAGE(PG8_SA(1, 0), cA + kstep, voffA); PG8_STAGE(PG8_SB(1, 1), cB + hstep + kstep, voffB);
        PG8_WAIT_V(6); PG8_BAR;
    } else {
        PG8_STAGE(PG8_SB(0, 0), cB, voffB); PG8_STAGE(PG8_SA(0, 0), cA, voffA); PG8_STAGE(PG8_SB(0, 1), cB + hstep, voffB); PG8_STAGE(PG8_SA(0, 1), cA + hstep, voffA);
        if (wr == 1) PG8_BAR;
        PG8_WAIT_V(4); PG8_BAR;
        PG8_STAGE(PG8_SB(1, 0), cB + kstep, voffB); PG8_STAGE(PG8_SA(1, 0), cA + kstep, voffA); PG8_STAGE(PG8_SB(1, 1), cB + hstep + kstep, voffB);
        PG8_WAIT_V(6); PG8_BAR;
    }
    for (;;) {
        const bool has_next = S.next(ui + 1, nxt);
        const char* nA = has_next ? (const char*)g.A + (size_t)nxt.pm * tstep : cA; const char* nB = has_next ? (const char*)g.Bt + (size_t)nxt.pn * tstep : cB;
        for (int t = 0; t < nt; t += 2) {
            const bool last = (t == nt - 2);
            const char* a1 = cA + (size_t)(t + 1) * kstep;
            const char* a2 = last ? nA : cA + (size_t)(t + 2) * kstep; const char* b2 = last ? nB : cB + (size_t)(t + 2) * kstep;
            const char* a3 = a2 + kstep; const char* b3 = b2 + kstep;
            if (last && has_next) S.a_ready(nxt);
            if constexpr (SP2) {
            PG8_LDB(B0, 0, 0); PG8_LDB(B1, 0, 1); PG8_SCHED; PG8_LDA(At, 0, 0); PG8_STAGE(PG8_SA(1, 1), a1 + hstep, voffA);
            PG8_WAIT_V(8); PG8_WAIT_L(0); PG8_BAR; PG8_MMA(0, 0, At, B0); PG8_MMA(0, 1, At, B1); PG8_BAR; PG8_SCHED;
            PG8_LDA(At, 0, 1); PG8_STAGE(PG8_SB(0, 0), b2, voffB); PG8_STAGE(PG8_SB(0, 1), b2 + hstep, voffB); PG8_STAGE(PG8_SA(0, 0), a2, voffA);
            PG8_WAIT_V(8); PG8_WAIT_L(0); PG8_BAR; PG8_MMA(1, 0, At, B0); PG8_MMA(1, 1, At, B1); PG8_BAR; PG8_SCHED;
            PG8_LDB(B0, 1, 0); PG8_LDB(B1, 1, 1); PG8_SCHED; PG8_LDA(At, 1, 0); PG8_STAGE(PG8_SA(0, 1), a2 + hstep, voffA);
            PG8_WAIT_V(8); PG8_WAIT_L(0); PG8_BAR; PG8_MMA(0, 0, At, B0); PG8_MMA(0, 1, At, B1); PG8_BAR; PG8_SCHED;
            PG8_LDA(At, 1, 1); PG8_STAGE(PG8_SB(1, 0), b3, voffB); PG8_STAGE(PG8_SB(1, 1), b3 + hstep, voffB); PG8_STAGE(PG8_SA(1, 0), a3, voffA);
            PG8_WAIT_V(8); PG8_WAIT_L(0); PG8_BAR; PG8_MMA(1, 0, At, B0); PG8_MMA(1, 1, At, B1); PG8_BAR; PG8_SCHED;
            } else {
            PG8_LDB(B0, 0, 0); PG8_SCHED; PG8_LDA(At, 0, 0); PG8_STAGE(PG8_SA(1, 1), a1 + hstep, voffA);
            PG8_WAIT_L(8); PG8_BAR; PG8_WAIT_L(0); PG8_MMA(0, 0, At, B0); PG8_BAR; PG8_SCHED;
            PG8_LDB(B1, 0, 1); PG8_STAGE(PG8_SB(0, 0), b2, voffB);
            PG8_BAR; PG8_WAIT_L(0); PG8_MMA(0, 1, At, B1); PG8_BAR;
            PG8_LDA(At, 0, 1); PG8_STAGE(PG8_SA(0, 0), a2, voffA);
            PG8_BAR; PG8_WAIT_L(0); PG8_MMA(1, 0, At, B0); PG8_BAR; PG8_SCHED;
            PG8_STAGE(PG8_SB(0, 1), b2 + hstep, voffB);
            PG8_WAIT_V(6); PG8_BAR; PG8_MMA(1, 1, At, B1); PG8_BAR;
            PG8_LDB(B0, 1, 0); PG8_SCHED; PG8_LDA(At, 1, 0); PG8_STAGE(PG8_SA(0, 1), a2 + hstep, voffA);
            PG8_WAIT_L(8); PG8_BAR; PG8_WAIT_L(0); PG8_MMA(0, 0, At, B0); PG8_BAR; PG8_SCHED;
            PG8_LDB(B1, 1, 1); PG8_STAGE(PG8_SB(1, 0), b3, voffB);
            PG8_BAR; PG8_WAIT_L(0); PG8_MMA(0, 1, At, B1); PG8_BAR;
            PG8_LDA(At, 1, 1); PG8_STAGE(PG8_SA(1, 0), a3, voffA);
            PG8_BAR; PG8_WAIT_L(0); PG8_MMA(1, 0, At, B0); PG8_BAR; PG8_SCHED;
            PG8_STAGE(PG8_SB(1, 1), b3 + hstep, voffB);
            PG8_WAIT_V(6); PG8_BAR; PG8_MMA(1, 1, At, B1); PG8_BAR;
            }
        }
        if constexpr (ALIGN_EPI) { if (wr == 0) PG8_BAR; }
        if constexpr (!Epi::AFTER_DRAIN) { E(acc, cur, wr, wc, fr, fq); S.done(cur); }
        if (!has_next) break;
#pragma unroll
        for (int a = 0; a < 2; ++a)
#pragma unroll
            for (int b = 0; b < 2; ++b)
#pragma unroll
                for (int m = 0; m < 4; ++m)
#pragma unroll
                    for (int n = 0; n < 2; ++n) acc[a][b][m][n] = (f32x4){0.f, 0.f, 0.f, 0.f};
        cur = nxt; cA = nA; cB = nB; ++ui;
        if constexpr (ALIGN_EPI) { if (wr == 1) PG8_BAR; }
    }
    PG8_WAIT_V(0);
    if constexpr (!ALIGN_EPI) { if (wr == 0) PG8_BAR; }
    PG8_BAR;
    if constexpr (Epi::AFTER_DRAIN) { E.fused(acc, cur, wr, wc, fr, fq, lds, wid, lane); S.done(cur); }
#undef PG8_SA
#undef PG8_SB
#undef PG8_STAGE
#undef PG8_LDA
#undef PG8_LDB
#undef PG8_MMA
#undef PG8_WAIT_V
#undef PG8_WAIT_L
#undef PG8_BAR
#undef PG8_SCHED
}
}

constexpr int NWAVES = 8;
constexpr int BATCH = 4, SEQ = 4096, DM = 1024, DEPTH = 4, BR = 256;
constexpr int MTOK = BATCH * SEQ;
constexpr int IN_COLS = 3336, NPAD = 3584, PLD = 3328;
constexpr int C_AVAL = 0, C_AGATE = 256, C_AZ = 512, C_BU = 768, C_BZ = 1024, C_CB = 1280, C_CC = 1536, C_CX = 1792, C_CZ = 2048,
              C_DQ = 2304, C_DK = 2560, C_DV = 2816, C_DZ = 3072;

constexpr size_t MiB = 1u << 20;
constexpr size_t WS_CTL = 0, CTL_ZERO_BYTES = 1 * MiB;
constexpr size_t WS_WIN = 2 * MiB;
constexpr size_t WIN_BYTES = (size_t)NPAD * DM * 2;
constexpr size_t WS_WOUT = 30 * MiB;
constexpr size_t WS_SMALL = 38 * MiB;
constexpr size_t WS_S5TAB = 39 * MiB;
constexpr size_t WS_PROJ = 60 * MiB;
constexpr size_t WS_AB = 164 * MiB;
constexpr size_t WS_PART = 165 * MiB;
constexpr size_t WS_MIXED = 166 * MiB;
constexpr size_t WS_XB = 198 * MiB;
constexpr size_t WS_SCR = 198 * MiB;
constexpr size_t WS_MISC = 238 * MiB;
constexpr size_t WS_END = 256 * MiB;

constexpr int CW_BAR = 4096;
constexpr int LDS_BYTES = 147456;
constexpr int RING_BYTES = 131072, LDSCTL_OFF = RING_BYTES, MISC_OFF = LDSCTL_OFF + 320;

#define GAS __attribute__((address_space(1)))
#define LAS __attribute__((address_space(3)))
typedef unsigned short bf16;
typedef unsigned v4u __attribute__((ext_vector_type(4)));
typedef unsigned v2u __attribute__((ext_vector_type(2)));
typedef float f32x4 __attribute__((ext_vector_type(4)));
typedef short bf16x8 __attribute__((ext_vector_type(8)));
#define LDS_WAIT() asm volatile("s_waitcnt lgkmcnt(0)" ::: "memory")
#define VM_WAIT() asm volatile("s_waitcnt vmcnt(0)" ::: "memory")
typedef __bf16 bf16x2h __attribute__((ext_vector_type(2)));
typedef float f32x2h __attribute__((ext_vector_type(2)));
__device__ __forceinline__ unsigned pk2(float lo, float hi) { return __builtin_bit_cast(unsigned, __builtin_convertvector((f32x2h){lo, hi}, bf16x2h)); }
__device__ __forceinline__ unsigned f2bf(float f) { return pk2(f, 0.f) & 0xffffu; }
__device__ __forceinline__ float bf2f(unsigned short u) { return __builtin_bit_cast(float, (unsigned)u << 16); }
__device__ __forceinline__ float bflo(unsigned u) { return __builtin_bit_cast(float, u << 16); }
__device__ __forceinline__ float bfhi(unsigned u) { return __builtin_bit_cast(float, u & 0xffff0000u); }
__device__ __forceinline__ float rcpf_(float x) { return __builtin_amdgcn_rcpf(x); }
__device__ __forceinline__ float rsqf_(float x) { return __builtin_amdgcn_rsqf(x); }
__device__ __forceinline__ float sigmoidf_(float x) { return rcpf_(1.0f + __expf(-x)); }
__device__ __forceinline__ float siluf_(float x) { return x * rcpf_(1.0f + __expf(-x)); }
__device__ __forceinline__ float geluf_(float x) { const float u = 0.7978845608028654f * (x + 0.044715f * x * x * x); return x * rcpf_(1.0f + __expf(-2.0f * u)); }
__device__ __forceinline__ float softplusf_(float x) { return x > 20.f ? x : log1pf(expf(x)); }
__device__ __forceinline__ float wave_sum(float v) {
#pragma unroll
    for (int o = 1; o < 64; o <<= 1) v += __shfl_xor(v, o);
    return v;
}

#define XB_TMO      128
#define XB_XCNT(j)  (256  + 64 * (j))
#define XB_XSUB(j)  (1280 + 64 * (j))
#define XB_XGEN(j)  (2304 + 64 * (j))
#define XB_TOP      3328
#define XB_TOPGEN   3392
#define XCD_BAR_WORDS 3456
#define XB_SPIN_CAP (1u << 24)

__device__ __forceinline__ unsigned xb_ld(unsigned* p)              { return __hip_atomic_load(p, __ATOMIC_RELAXED, __HIP_MEMORY_SCOPE_AGENT); }
__device__ __forceinline__ unsigned xb_add(unsigned* p, unsigned v) { return __hip_atomic_fetch_add(p, v, __ATOMIC_RELAXED, __HIP_MEMORY_SCOPE_AGENT); }
__device__ __forceinline__ unsigned xb_xcc_id() { return (unsigned)__builtin_amdgcn_s_getreg((3 << 11) | 20) & 0xFu; }
#define XB_SPIN(cond, bar) do { unsigned _sp = 0; while (cond) { __builtin_amdgcn_s_sleep(1); \
    if ((++_sp & 255u) == 0u) { if (xb_ld(&(bar)[XB_TMO])) break; if (_sp > XB_SPIN_CAP) { atomicAdd(&(bar)[XB_TMO], 1u); break; } } } } while (0)

struct XcdBarrier {
    unsigned* bar; unsigned x;
    volatile LAS unsigned* st;
};

__device__ __forceinline__ XcdBarrier xcd_barrier_post(unsigned* bar, volatile LAS unsigned* st) {
    XcdBarrier b; b.bar = bar; b.x = xb_xcc_id(); b.st = st;
    if (threadIdx.x == 0) (void)xb_add(&bar[XB_XCNT(b.x)], 1u);
    return b;
}
__device__ __forceinline__ void xcd_barrier_complete(unsigned* bar, unsigned x, unsigned& nloc, unsigned& nx) {
    const unsigned G = gridDim.x * gridDim.y * gridDim.z;
    unsigned sum, cnt, mine, sp = 0u;
    for (;;) {
        sum = 0u; cnt = 0u; mine = 0u;
#pragma unroll
        for (unsigned j = 0; j < 16; ++j) { const unsigned c = xb_ld(&bar[XB_XCNT(j)]); sum += c; cnt += (c > 0u) ? 1u : 0u; mine = (j == x) ? c : mine; }
        if (sum == G) break;
        __builtin_amdgcn_s_sleep(1);
        if ((++sp & 255u) == 0u) { if (xb_ld(&bar[XB_TMO])) break; if (sp > XB_SPIN_CAP) { atomicAdd(&bar[XB_TMO], 1u); break; } }
    }
    nloc = mine > 0u ? mine : 1u; nx = cnt > 0u ? cnt : 1u;
}

__device__ __forceinline__ void xcd_barrier(const XcdBarrier& b) {
    asm volatile("s_waitcnt vmcnt(0)" ::: "memory");
    __syncthreads();
    if (threadIdx.x == 0) {
        unsigned* bar = b.bar;
        __builtin_amdgcn_s_waitcnt(0);
        unsigned nloc = b.st[0], nx = b.st[1];
        if (nloc == 0u) { xcd_barrier_complete(bar, b.x, nloc, nx); b.st[0] = nloc; b.st[1] = nx; }
        const unsigned old = xb_add(&bar[XB_XSUB(b.x)], 1u);
        const unsigned gen = old / nloc;
        if (old + 1u == (gen + 1u) * nloc) {
            __builtin_amdgcn_fence(__ATOMIC_RELEASE, "agent");
            asm volatile("s_waitcnt vmcnt(0)" ::: "memory");
            const unsigned og = xb_add(&bar[XB_TOP], 1u);
            const unsigned tg = og / nx;
            if (og + 1u == (tg + 1u) * nx) xb_add(&bar[XB_TOPGEN], 1u);
            else XB_SPIN(xb_ld(&bar[XB_TOPGEN]) == tg, bar);
            __builtin_amdgcn_fence(__ATOMIC_ACQUIRE, "agent");
            xb_add(&bar[XB_XGEN(b.x)], 1u);
            asm volatile("s_waitcnt vmcnt(0)" ::: "memory");
        } else {
            XB_SPIN(xb_ld(&bar[XB_XGEN(b.x)]) == gen, bar);
            __builtin_amdgcn_fence(__ATOMIC_ACQUIRE, "agent");
            asm volatile("s_waitcnt vmcnt(0)" ::: "memory");
        }
    }
    __syncthreads();
}


struct Args { const float* in[26]; float* out; unsigned char* ws; int ph_lo, ph_hi, layer, pad; };
enum { I_X = 0, I_NORMG, I_WIN, I_ACW, I_ACB, I_ALG, I_ALB, I_APW, I_APB, I_LRE, I_LIM, I_BRE, I_BIM, I_CRE, I_CIM, I_S5D, I_LOGDT, I_GLUW, I_GLUB,
       I_CCW, I_DCW, I_ALOG, I_DTB, I_DNG, I_WOUT, I_FING };

__device__ __forceinline__ const float* inptr(int i) {
    typedef const float* cfp;
    const __attribute__((address_space(4))) cfp* base = (const __attribute__((address_space(4))) cfp*)__builtin_amdgcn_kernarg_segment_ptr();
    asm volatile("" : "+s"(i));
    return (const float*)(const GAS float*)base[i];
}
__device__ __forceinline__ int win_dest(int n) { return n < 3072 ? n : (n < 3080 ? n + 256 : n - 8); }
__device__ __forceinline__ void p0_transpose_item(const float* W, int K, int N, bf16* WT, LAS float* scr, int item, int lane, const float* gs, bool perm) {
    const int nblk = (N + 31) / 32, kb = item / nblk, nb = item % nblk, k0 = 64 * kb, n0 = 32 * nb;
    float tv[32];
#pragma unroll
    for (int i = 0; i < 32; ++i) { const int kk = 2 * i + (lane >> 5); const int n = n0 + (lane & 31);
        tv[i] = (n < N) ? W[(size_t)(k0 + kk) * N + n] : 0.f; }
    const float g0 = gs ? gs[k0 + (lane >> 5) + 2 * (lane & 31)] : 1.f;
#pragma unroll
    for (int i = 0; i < 32; ++i) { const int kk = 2 * i + (lane >> 5);
        const float g = __shfl(g0, i + (lane & 32));
        scr[kk * 33 + (lane & 31)] = tv[i] * g; }
    LDS_WAIT(); asm volatile("" ::: "memory");
    const int c = lane & 7;
#pragma unroll
    for (int j = 0; j < 4; ++j) { const int nl = (lane >> 3) + 8 * j; const int n = n0 + nl; const LAS float* s = scr + (8 * c) * 33 + nl;
        v4u o; o.x = pk2(s[0 * 33], s[1 * 33]); o.y = pk2(s[2 * 33], s[3 * 33]); o.z = pk2(s[4 * 33], s[5 * 33]); o.w = pk2(s[6 * 33], s[7 * 33]);
        if (n < N) { const int dn = perm ? win_dest(n) : n; *(GAS v4u*)(WT + (size_t)dn * K + k0 + 8 * c) = o; } }
    LDS_WAIT(); asm volatile("" ::: "memory");
}

__device__ __forceinline__ void phase_prologue(const Args& a, unsigned char* ws, LAS unsigned char* lds, int gw, int NGW, int wave, int lane) {
    LAS float* scr = (LAS float*)(lds + wave * 16384);
    constexpr int I_WIN_L = (DM / 64) * ((IN_COLS + 31) / 32);
    constexpr int I_WOUT_L = (DM / 64) * (DM / 32);
    constexpr int I_SM_L = (BR / 64) * (BR / 32);
    constexpr int PER_L = I_WIN_L + I_WOUT_L + 2 * I_SM_L;
    for (int rnd = 0; ; ++rnd) {
        const int it = gw + rnd * NGW; if (it >= DEPTH * PER_L) break;
        const int l = it / PER_L; int r = it % PER_L;
        if (r < I_WIN_L) { p0_transpose_item(inptr(I_WIN) + (size_t)l * DM * IN_COLS, DM, IN_COLS, (bf16*)(ws + WS_WIN + l * WIN_BYTES), scr, r, lane, inptr(I_NORMG) + l * DM, true); continue; } r -= I_WIN_L;
        if (r < I_WOUT_L) { p0_transpose_item(inptr(I_WOUT) + (size_t)l * DM * DM, DM, DM, (bf16*)(ws + WS_WOUT + (size_t)l * 2 * MiB), scr, r, lane, nullptr, false); continue; } r -= I_WOUT_L;
        if (r < I_SM_L) { p0_transpose_item(inptr(I_APW) + (size_t)l * BR * BR, BR, BR, (bf16*)(ws + WS_SMALL + (size_t)l * 262144), scr, r, lane, nullptr, false); continue; } r -= I_SM_L;
        p0_transpose_item(inptr(I_GLUW) + (size_t)l * BR * BR, BR, BR, (bf16*)(ws + WS_SMALL + (size_t)l * 262144 + 131072), scr, r, lane, nullptr, false);
    }
    for (int it = gw; it < DEPTH * (NPAD - IN_COLS); it += NGW) {
        const int l = it / (NPAD - IN_COLS), r = IN_COLS + it % (NPAD - IN_COLS);
        GAS v4u* p = (GAS v4u*)(ws + WS_WIN + l * WIN_BYTES + (size_t)r * DM * 2);
        p[lane] = (v4u){0u, 0u, 0u, 0u}; p[lane + 64] = (v4u){0u, 0u, 0u, 0u};
    }
    const float* x = inptr(I_X); bf16* xb = (bf16*)a.out; float* part = (float*)(ws + WS_PART);
    for (int m = gw; m < MTOK; m += NGW) {
        const GAS f32x4* xr = (const GAS f32x4*)(x + (size_t)m * DM) + lane;
        f32x4 v[4]; float s = 0.f;
#pragma unroll
        for (int j = 0; j < 4; ++j) { v[j] = xr[64 * j]; s += (v[j][0] * v[j][0] + v[j][1] * v[j][1]) + (v[j][2] * v[j][2] + v[j][3] * v[j][3]); }
        s = wave_sum(s);
        GAS v2u* o8 = (GAS v2u*)(xb + (size_t)m * DM) + lane;
#pragma unroll
        for (int j = 0; j < 4; ++j) { v2u w; w.x = pk2(v[j][0], v[j][1]); w.y = pk2(v[j][2], v[j][3]); o8[64 * j] = w; }
        if (lane < 16) part[(size_t)m * 16 + lane] = (lane == 0) ? s : 0.f;
    }
}

__device__ __forceinline__ void phase_final_norm(const Args& a, const bf16* xl, int gw, int NGW, int lane) {
    const float* fg = inptr(I_FING);
    f32x4 g[4];
#pragma unroll
    for (int j = 0; j < 4; ++j) g[j] = ((const GAS f32x4*)fg)[lane + 64 * j];
    for (int m = gw; m < MTOK; m += NGW) {
        const GAS v2u* xr = (const GAS v2u*)(xl + (size_t)m * DM) + lane;
        GAS f32x4* orow = (GAS f32x4*)(a.out + (size_t)m * DM) + lane;
        f32x4 v[4]; float s = 0.f;
#pragma unroll
        for (int j = 0; j < 4; ++j) { const v2u w = xr[64 * j]; v[j] = (f32x4){bflo(w.x), bfhi(w.x), bflo(w.y), bfhi(w.y)}; s += (v[j][0] * v[j][0] + v[j][1] * v[j][1]) + (v[j][2] * v[j][2] + v[j][3] * v[j][3]); }
        s = wave_sum(s);
        const float rstd = rsqf_(s * (1.0f / DM) + 1e-6f);
#pragma unroll
        for (int j = 0; j < 4; ++j) orow[64 * j] = v[j] * rstd * g[j];
    }
}


constexpr size_t MISC_SP = 0, MISC_BT = 8 * MiB, MISC_XLOC = 16 * MiB, CTL_EGL = 512 * 1024;
constexpr int DNL_WAVE_LDS = 65024;
#define MFMA16(a, b, c) __builtin_amdgcn_mfma_f32_16x16x32_bf16(a, b, c, 0, 0, 0)
__device__ __forceinline__ v2u pack4(const f32x4 v) { v2u w; w.x = pk2(v[0], v[1]); w.y = pk2(v[2], v[3]); return w; }
__device__ __forceinline__ bf16x8 pack8(const f32x4 a, const f32x4 b) { v4u w; w.x = pk2(a[0], a[1]); w.y = pk2(a[2], a[3]); w.z = pk2(b[0], b[1]); w.w = pk2(b[2], b[3]); return __builtin_bit_cast(bf16x8, w); }
__device__ __forceinline__ void unpack8(const v4u r, float (&x)[8]) { x[0] = bflo(r.x); x[1] = bfhi(r.x); x[2] = bflo(r.y); x[3] = bfhi(r.y); x[4] = bflo(r.z); x[5] = bfhi(r.z); x[6] = bflo(r.w); x[7] = bfhi(r.w); }

constexpr size_t S5G_BYTES = 335872;
constexpr int S5_POW = 0, S5_KT = 36864, S5_CC = 69632, S5_BM = 73728;
typedef float f32x2v __attribute__((ext_vector_type(2)));

__device__ __forceinline__ f32x2v cmul_(f32x2v a, f32x2v b) { return (f32x2v){a.x * b.x - a.y * b.y, a.x * b.y + a.y * b.x}; }
__device__ __forceinline__ void s5_tables(unsigned char* ws, LAS unsigned char* lds, int item, int tid) {
    const int lg = item >> 2, q = item & 3;
    unsigned char* tb = ws + WS_S5TAB + (size_t)lg * S5G_BYTES;
    f32x2v* gPOW = (f32x2v*)(tb + S5_POW); bf16* gKT = (bf16*)(tb + S5_KT); bf16* gCC = (bf16*)(tb + S5_CC); bf16* gBM = (bf16*)(tb + S5_BM);
    LAS f32x2v* POWs = (LAS f32x2v*)lds; LAS f32x2v* BBs = (LAS f32x2v*)(lds + 33280); LAS f32x2v* Cs = (LAS f32x2v*)(lds + 41472);
    const float* lre = inptr(I_LRE) + lg * 64; const float* lim = inptr(I_LIM) + lg * 64;
    __syncthreads();
    const float dt = expf(inptr(I_LOGDT)[lg]);
    float lr_[2], li_[2], br_[2], bi_[2], cr_[2], ci_[2];
#pragma unroll
    for (int k = 0; k < 2; ++k) { const int e = tid + 512 * k, p = e >> 4, h = e & 15;
        lr_[k] = fminf(lre[p], -1e-4f); li_[k] = lim[p]; br_[k] = inptr(I_BRE)[(lg * 64 + p) * 16 + h]; bi_[k] = inptr(I_BIM)[(lg * 64 + p) * 16 + h];
        cr_[k] = inptr(I_CRE)[lg * 1024 + e]; ci_[k] = inptr(I_CIM)[lg * 1024 + e]; }
    {
        const int p = tid & 63, j = tid >> 6; const float lr = fminf(lre[p], -1e-4f) * dt, li = lim[p] * dt;
        const float mag = expf(lr); float sn, cs; sincosf(li, &sn, &cs);
        const f32x2v l1 = (f32x2v){mag * cs, mag * sn}, l2 = cmul_(l1, l1), l4 = cmul_(l2, l2), l8 = cmul_(l4, l4);
        f32x2v cur = (f32x2v){1.f, 0.f};
        if (j & 1) cur = cmul_(cur, l1);
        if (j & 2) cur = cmul_(cur, l2);
        if (j & 4) cur = cmul_(cur, l4);
#pragma unroll
        for (int i = 0; i < 9; ++i) {
            const int t = j + 8 * i;
            if (t <= 64) { POWs[t * 64 + p] = cur; if (q == 0) gPOW[t * 64 + p] = cur; }
            cur = cmul_(cur, l8);
        }
    }
#pragma unroll
    for (int k = 0; k < 2; ++k) { const int e = tid + 512 * k; const float lr = lr_[k], li = li_[k];
        const float mag = expf(lr * dt); float sn, cs; sincosf(li * dt, &sn, &cs);
        const float ar = mag * cs - 1.f, ai = mag * sn, den = lr * lr + li * li;
        const float cfr = (ar * lr + ai * li) / den, cfi = (ai * lr - ar * li) / den;
        BBs[e] = (f32x2v){cfr * br_[k] - cfi * bi_[k], cfr * bi_[k] + cfi * br_[k]};
        Cs[e] = (f32x2v){cr_[k], ci_[k]}; }
    __syncthreads();
    {
        const int wv = tid >> 6, ln_ = tid & 15, gq_ = (tid >> 4) & 3;
        bf16x8 bh[4], bl[4];
#pragma unroll
        for (int ks = 0; ks < 4; ++ks) {
            const LAS f32x4* pq = (const LAS f32x4*)(POWs + (16 * q + ln_) * 64 + 16 * ks + 4 * gq_);
            const f32x4 v0 = pq[0], v1 = pq[1];
            v4u hi, lo;
            hi.x = pk2(v0[0], v0[1]); hi.y = pk2(v0[2], v0[3]); hi.z = pk2(v1[0], v1[1]); hi.w = pk2(v1[2], v1[3]);
            lo.x = pk2(v0[0] - bflo(hi.x), v0[1] - bfhi(hi.x)); lo.y = pk2(v0[2] - bflo(hi.y), v0[3] - bfhi(hi.y)); lo.z = pk2(v1[0] - bflo(hi.z), v1[1] - bfhi(hi.z)); lo.w = pk2(v1[2] - bflo(hi.w), v1[3] - bfhi(hi.w));
            bh[ks] = __builtin_bit_cast(bf16x8, hi); bl[ks] = __builtin_bit_cast(bf16x8, lo);
        }
        bf16x8 ah[2][4], al[2][4];
#pragma unroll
        for (int mt2 = 0; mt2 < 2; ++mt2)
#pragma unroll
            for (int ks = 0; ks < 4; ++ks) {
                float x[8];
#pragma unroll
                for (int j = 0; j < 4; ++j) { const int pp = 16 * ks + 4 * gq_ + j; const f32x2v c = Cs[(2 * wv + mt2) * 64 + pp], bb = BBs[pp * 16 + ln_];
                    x[2 * j] = c.x * bb.x - c.y * bb.y; x[2 * j + 1] = -(c.x * bb.y + c.y * bb.x); }
                v4u hi, lo;
                hi.x = pk2(x[0], x[1]); hi.y = pk2(x[2], x[3]); hi.z = pk2(x[4], x[5]); hi.w = pk2(x[6], x[7]);
                lo.x = pk2(x[0] - bflo(hi.x), x[1] - bfhi(hi.x)); lo.y = pk2(x[2] - bflo(hi.y), x[3] - bfhi(hi.y)); lo.z = pk2(x[4] - bflo(hi.z), x[5] - bfhi(hi.z)); lo.w = pk2(x[6] - bflo(hi.w), x[7] - bfhi(hi.w));
                ah[mt2][ks] = __builtin_bit_cast(bf16x8, hi); al[mt2][ks] = __builtin_bit_cast(bf16x8, lo);
            }
        __builtin_amdgcn_sched_barrier(0);
#pragma unroll
        for (int mt2 = 0; mt2 < 2; ++mt2) {
            f32x4 acc = (f32x4){0.f, 0.f, 0.f, 0.f};
#pragma unroll
            for (int ks = 0; ks < 4; ++ks) { acc = MFMA16(al[mt2][ks], bh[ks], acc); acc = MFMA16(ah[mt2][ks], bl[ks], acc); acc = MFMA16(ah[mt2][ks], bh[ks], acc); }
            *(v2u*)(gKT + ((2 * wv + mt2) * 64 + 16 * q + ln_) * 16 + 4 * gq_) = pack4(acc);
        }
        __builtin_amdgcn_sched_barrier(0);
    }
#pragma unroll 2
    for (int k = 0; k < 4; ++k) {
        const int u = tid + 512 * k, cl = u & 31, p = u >> 5, chunk = 32 * q + cl, sx = chunk >> 1, h0 = (chunk & 1) * 8;
        const f32x2v pw = POWs[(63 - sx) * 64 + p];
        float vr[8], vi[8];
#pragma unroll
        for (int e = 0; e < 8; ++e) { const f32x2v bb = BBs[p * 16 + h0 + e]; vr[e] = pw.x * bb.x - pw.y * bb.y; vi[e] = pw.x * bb.y + pw.y * bb.x; }
        v4u w; w.x = pk2(vr[0], vr[1]); w.y = pk2(vr[2], vr[3]); w.z = pk2(vr[4], vr[5]); w.w = pk2(vr[6], vr[7]);
        *(v4u*)(gBM + (size_t)(2 * p) * 1024 + chunk * 8) = w;
        w.x = pk2(vi[0], vi[1]); w.y = pk2(vi[2], vi[3]); w.z = pk2(vi[4], vi[5]); w.w = pk2(vi[6], vi[7]);
        *(v4u*)(gBM + (size_t)(2 * p + 1) * 1024 + chunk * 8) = w;
    }
    if (q == 0) {
        for (int k = 0; k < 4; ++k) {
            const int e = tid + 512 * k, h = e >> 7, k2 = e & 127, p = k2 >> 1, ri = k2 & 1;
            const f32x2v c = Cs[h * 64 + p];
            gCC[e] = (bf16)f2bf(ri ? -c.y : c.x);
        }
    }
}

__device__ __forceinline__ void s5_xloc(int l, unsigned char* ws, int item, int wave, int lane) {
    asm volatile("" : "+v"(lane));
    const int g = item >> 4, cs = item & 15, gq = lane >> 4, ln = lane & 15;
    const bf16* proj = (const bf16*)(ws + WS_PROJ);
    const bf16* gBM = (const bf16*)(ws + WS_S5TAB + (size_t)(l * 16 + g) * S5G_BYTES + S5_BM);
    const bf16* ap = gBM + (size_t)(16 * wave + ln) * 1024 + 8 * gq;
    const bf16* bp = proj + (size_t)((cs * 16 + ln) * 64 + (gq >> 1)) * PLD + C_BU + g * 16 + 8 * (gq & 1);
    f32x4 acc = (f32x4){0.f, 0.f, 0.f, 0.f};
#pragma unroll 8
    for (int ks = 0; ks < 32; ++ks) {
        const bf16x8 a = *(const bf16x8*)(ap + 32 * ks);
        const bf16x8 b = *(const bf16x8*)(bp + (size_t)(2 * ks) * PLD);
        acc = MFMA16(a, b, acc);
    }
    float* xl = (float*)(ws + WS_MISC + MISC_XLOC) + ((size_t)(cs * 16 + ln) * 16 + g) * 128 + 16 * wave + 4 * gq;
    *(f32x4*)xl = acc;
}

__device__ __forceinline__ void s5_scan(int l, unsigned char* ws, int e) {
    const int b = e >> 10, g = (e >> 6) & 15, p = e & 63;
    const f32x2v lc = ((const f32x2v*)(ws + WS_S5TAB + (size_t)(l * 16 + g) * S5G_BYTES + S5_POW))[64 * 64 + p];
    f32x2v* xp = (f32x2v*)((float*)(ws + WS_MISC + MISC_XLOC) + ((size_t)(b * 64) * 16 + g) * 128) + p;
    float xr = 0.f, xi = 0.f;
#pragma unroll 1
    for (int n0 = 0; n0 < 64; n0 += 32) {
        f32x2v v[32];
#pragma unroll
        for (int j = 0; j < 32; ++j) v[j] = xp[(size_t)(n0 + j) * 1024];
#pragma unroll
        for (int j = 0; j < 32; ++j) {
            xp[(size_t)(n0 + j) * 1024] = (f32x2v){xr, xi};
            const float nr = lc.x * xr - lc.y * xi + v[j].x, ni = lc.x * xi + lc.y * xr + v[j].y; xr = nr; xi = ni;
        }
    }
}

constexpr int S5O_YL = 65536, S5O_YLD = 528;
#define S5_LOADB(dst, kp, qb) do { _Pragma("unroll") for (int q_ = 0; q_ < 16; ++q_) dst[q_] = *(const bf16x8*)((kp) + 32 * ((qb) + q_)); } while (0)
#define S5_TOEP(src, ub, qb) do { _Pragma("unroll") for (int q_ = 0; q_ < 8; ++q_) { _Pragma("unroll") for (int mt = 0; mt < 4; ++mt) { if (8 * mt + 7 >= (qb) + q_) { \
        const bf16x8 afr_ = *(const LAS bf16x8*)((ub) + (16 * mt - 2 * ((qb) + q_)) * 32); acc[mt] = MFMA16(afr_, src[q_], acc[mt]); \
        if (mt < 3) acc[mt < 3 ? mt + 1 : 3] = MFMA16(afr_, src[q_ + 8], acc[mt < 3 ? mt + 1 : 3]); } } } } while (0)
__device__ __forceinline__ void s5_state_epi(int l, unsigned char* ws, const unsigned char* tb, const float* xin, const LAS unsigned char* UL, LAS unsigned char* YL, int g, f32x4 (&acc)[4], int gq, int ln) {
    const bf16* gCC = (const bf16*)(tb + S5_CC); const float* gPOW = (const float*)(tb + S5_POW);
    {
        bf16x8 cfr[4]; f32x4 z0[4], z1[4], l0[4], l1[4];
#pragma unroll
        for (int ks = 0; ks < 4; ++ks) {
            cfr[ks] = *(const bf16x8*)(gCC + ln * 128 + 32 * ks + 8 * gq);
            const f32x4 x0 = *(const f32x4*)(xin + 2 * (16 * ks + 4 * gq)), x1 = *(const f32x4*)(xin + 2 * (16 * ks + 4 * gq) + 4);
            const float* pp = gPOW + ((ln + 1) * 64 + 16 * ks + 4 * gq) * 2;
            const f32x4 p0 = *(const f32x4*)pp, p1 = *(const f32x4*)(pp + 4);
            const float* lp = gPOW + (16 * 64 + 16 * ks + 4 * gq) * 2;
            l0[ks] = *(const f32x4*)lp; l1[ks] = *(const f32x4*)(lp + 4);
            z0[ks] = (f32x4){p0[0] * x0[0] - p0[1] * x0[1], p0[0] * x0[1] + p0[1] * x0[0], p0[2] * x0[2] - p0[3] * x0[3], p0[2] * x0[3] + p0[3] * x0[2]};
            z1[ks] = (f32x4){p1[0] * x1[0] - p1[1] * x1[1], p1[0] * x1[1] + p1[1] * x1[0], p1[2] * x1[2] - p1[3] * x1[3], p1[2] * x1[3] + p1[3] * x1[2]};
        }
#pragma unroll
        for (int mt = 0; mt < 4; ++mt) {
#pragma unroll
            for (int ks = 0; ks < 4; ++ks) {
                acc[mt] = MFMA16(pack8(z0[ks], z1[ks]), cfr[ks], acc[mt]);
                if (mt < 3) {
                    const f32x4 a = z0[ks], b2 = z1[ks], la = l0[ks], lb = l1[ks];
                    z0[ks] = (f32x4){la[0] * a[0] - la[1] * a[1], la[0] * a[1] + la[1] * a[0], la[2] * a[2] - la[3] * a[3], la[2] * a[3] + la[3] * a[2]};
                    z1[ks] = (f32x4){lb[0] * b2[0] - lb[1] * b2[1], lb[0] * b2[1] + lb[1] * b2[0], lb[2] * b2[2] - lb[3] * b2[3], lb[2] * b2[3] + lb[3] * b2[2]};
                }
            }
        }
    }
    const float dsk = inptr(I_S5D)[l * 256 + g * 16 + ln];
#pragma unroll
    for (int mt = 0; mt < 4; ++mt)
#pragma unroll
        for (int r = 0; r < 4; ++r) {
            const int t = 16 * mt + 4 * gq + r;
            const float u = bf2f(*(const LAS unsigned short*)(UL + (64 + t) * 32 + ln * 2));
            *(LAS unsigned short*)(YL + t * S5O_YLD + (g * 16 + ln) * 2) = (unsigned short)f2bf(geluf_(acc[mt][r] + dsk * u));
        }
}
__device__ __forceinline__ void s5_out(int l, unsigned char* ws, LAS unsigned char* lds, int ci, int wave, int lane) {
    asm volatile("" : "+v"(lane));
    const int gq = lane >> 4, ln = lane & 15;
    const bf16* proj = (const bf16*)(ws + WS_PROJ); bf16* mixed = (bf16*)(ws + WS_MIXED);
    const size_t tok0 = (size_t)ci * 64;
    LAS unsigned char* UL0 = lds + wave * 8192; LAS unsigned char* UL1 = UL0 + 4096; LAS unsigned char* YL = lds + S5O_YL;
    const int g0 = 2 * wave, g1 = g0 + 1;
    const unsigned char* tb0 = ws + WS_S5TAB + (size_t)(l * 16 + g0) * S5G_BYTES; const unsigned char* tb1 = tb0 + S5G_BYTES;
    const bf16* kp0 = (const bf16*)(tb0 + S5_KT) + (ln * 64 + (gq >> 1)) * 16 + 8 * (gq & 1);
    const bf16* kp1 = (const bf16*)(tb1 + S5_KT) + (ln * 64 + (gq >> 1)) * 16 + 8 * (gq & 1);
    const float* xin0 = (const float*)(ws + WS_MISC + MISC_XLOC) + ((size_t)ci * 16 + g0) * 128;
    bf16x8 bA[16], bB[16];
    S5_LOADB(bA, kp0, 0);
    const bf16* up = proj + (tok0 + lane) * PLD + C_BU + g0 * 16;
    const v4u u00 = *(const v4u*)up, u01 = *(const v4u*)(up + 8), u10 = *(const v4u*)(up + 16), u11 = *(const v4u*)(up + 24);
    __syncthreads();
    const v4u z4 = (v4u){0u, 0u, 0u, 0u};
    *(LAS v4u*)(UL0 + lane * 32) = z4; *(LAS v4u*)(UL0 + lane * 32 + 16) = z4; *(LAS v4u*)(UL1 + lane * 32) = z4; *(LAS v4u*)(UL1 + lane * 32 + 16) = z4;
    *(LAS v4u*)(UL0 + (64 + lane) * 32) = u00; *(LAS v4u*)(UL0 + (64 + lane) * 32 + 16) = u01;
    *(LAS v4u*)(UL1 + (64 + lane) * 32) = u10; *(LAS v4u*)(UL1 + (64 + lane) * 32 + 16) = u11;
    S5_LOADB(bB, kp0, 16);
    LDS_WAIT();
    const LAS unsigned char* ub0 = UL0 + (64 + ln - (gq >> 1)) * 32 + 16 * (gq & 1);
    const LAS unsigned char* ub1 = UL1 + (64 + ln - (gq >> 1)) * 32 + 16 * (gq & 1);
    {
        f32x4 acc[4];
#pragma unroll
        for (int mt = 0; mt < 4; ++mt) acc[mt] = (f32x4){0.f, 0.f, 0.f, 0.f};
        S5_TOEP(bA, ub0, 0);
        S5_LOADB(bA, kp1, 0);
        S5_TOEP(bB, ub0, 16);
        __builtin_amdgcn_sched_barrier(0);
        s5_state_epi(l, ws, tb0, xin0, UL0, YL, g0, acc, gq, ln);
        __builtin_amdgcn_sched_barrier(0);
    }
    {
        f32x4 acc[4];
#pragma unroll
        for (int mt = 0; mt < 4; ++mt) acc[mt] = (f32x4){0.f, 0.f, 0.f, 0.f};
        S5_LOADB(bB, kp1, 16);
        S5_TOEP(bA, ub1, 0);
        S5_TOEP(bB, ub1, 16);
        __builtin_amdgcn_sched_barrier(0);
        s5_state_epi(l, ws, tb1, xin0 + 128, UL1, YL, g1, acc, gq, ln);
        __builtin_amdgcn_sched_barrier(0);
    }
    const bf16* gw = (const bf16*)(ws + WS_SMALL + (size_t)l * 262144 + 131072);
    const float* gb = inptr(I_GLUB) + l * 256;
    bf16x8 afr[8], afr1[8]; v2u zv[2][4];
#pragma unroll
    for (int ks = 0; ks < 8; ++ks) afr[ks] = *(const bf16x8*)(gw + (size_t)(32 * wave + ln) * 256 + 32 * ks + 8 * gq);
#pragma unroll
    for (int nt2 = 0; nt2 < 2; ++nt2)
#pragma unroll
        for (int tt = 0; tt < 4; ++tt) zv[nt2][tt] = *(const v2u*)(proj + (tok0 + 16 * tt + ln) * PLD + C_BZ + 32 * wave + 16 * nt2 + 4 * gq);
    LDS_WAIT(); __syncthreads();
#pragma unroll
    for (int nt2 = 0; nt2 < 2; ++nt2) {
        const int n0 = 32 * wave + 16 * nt2;
        f32x4 acc[4];
#pragma unroll
        for (int tt = 0; tt < 4; ++tt) acc[tt] = (f32x4){0.f, 0.f, 0.f, 0.f};
        if (nt2 == 0) {
#pragma unroll
            for (int ks = 0; ks < 8; ++ks) afr1[ks] = *(const bf16x8*)(gw + (size_t)(32 * wave + 16 + ln) * 256 + 32 * ks + 8 * gq);
        }
#pragma unroll
        for (int ks = 0; ks < 8; ++ks) {
#pragma unroll
            for (int tt = 0; tt < 4; ++tt) {
                const bf16x8 bfr = *(const LAS bf16x8*)(YL + (16 * tt + ln) * S5O_YLD + (32 * ks + 8 * gq) * 2);
                acc[tt] = MFMA16(nt2 ? afr1[ks] : afr[ks], bfr, acc[tt]);
            }
        }
        const f32x4 bias = *(const f32x4*)(gb + n0 + 4 * gq);
#pragma unroll
        for (int tt = 0; tt < 4; ++tt) {
            const int t = 16 * tt + ln; const int nn = n0 + 4 * gq;
            const v2u yv = *(const LAS v2u*)(YL + t * S5O_YLD + nn * 2);
            const v2u z = zv[nt2][tt];
            f32x4 o;
            o[0] = bflo(yv.x) * sigmoidf_(acc[tt][0] + bias[0]) * siluf_(bflo(z.x));
            o[1] = bfhi(yv.x) * sigmoidf_(acc[tt][1] + bias[1]) * siluf_(bfhi(z.x));
            o[2] = bflo(yv.y) * sigmoidf_(acc[tt][2] + bias[2]) * siluf_(bflo(z.y));
            o[3] = bfhi(yv.y) * sigmoidf_(acc[tt][3] + bias[3]) * siluf_(bfhi(z.y));
            *(v2u*)(mixed + (tok0 + t) * DM + 256 + nn) = pack4(o);
        }
    }
}
constexpr int AB_CV = 49152, AB_ACTLD = 528;
__device__ __forceinline__ void a_branch(int l, unsigned char* ws, LAS unsigned char* lds, int ci, int tid) {
    asm volatile("" : "+v"(tid));
    const int lane = tid & 63, wave = tid >> 6, gq = lane >> 4, ln = lane & 15;
    const bf16* proj = (const bf16*)(ws + WS_PROJ); bf16* mixed = (bf16*)(ws + WS_MIXED);
    const size_t tok0 = (size_t)ci * 64; const int n = ci & 63;
    LAS unsigned char* AT = lds; LAS float* CV = (LAS float*)(lds + AB_CV); LAS unsigned char* ACT = lds;
    __syncthreads();
    {
        const int c8 = tid & 31, r0 = tid >> 5;
        v4u rv[6], rg[6];
#pragma unroll
        for (int ps = 0; ps < 6; ++ps) {
            const int rr = r0 + 16 * ps;
            rv[ps] = (v4u){0u, 0u, 0u, 0u}; rg[ps] = (v4u){0u, 0u, 0u, 0u};
            if (rr < 94 && (n > 0 || rr >= 30)) { const bf16* p = proj + (tok0 + rr - 30) * PLD + c8 * 8; rv[ps] = *(const v4u*)(p + C_AVAL); rg[ps] = *(const v4u*)(p + C_AGATE); }
        }
#pragma unroll
        for (int ps = 0; ps < 6; ++ps) {
            const int rr = r0 + 16 * ps;
            if (rr < 94) {
                float v[8], gt[8]; unpack8(rv[ps], v); unpack8(rg[ps], gt);
#pragma unroll
                for (int e = 0; e < 8; ++e) v[e] *= sigmoidf_(gt[e]);
                v4u w; w.x = pk2(v[0], v[1]); w.y = pk2(v[2], v[3]); w.z = pk2(v[4], v[5]); w.w = pk2(v[6], v[7]);
                *(LAS v4u*)(AT + rr * 512 + c8 * 16) = w;
            }
        }
    }
    __syncthreads();
    {
        const int c = tid & 255, th = tid >> 8;
        const float* cw = inptr(I_ACW) + l * 31 * 256 + c;
        float w[31];
#pragma unroll
        for (int k = 0; k < 31; ++k) w[k] = cw[k * 256];
        const float bias = inptr(I_ACB)[l * 256 + c];
        float out[32];
#pragma unroll
        for (int i = 0; i < 32; ++i) out[i] = bias;
#pragma unroll
        for (int rr = 0; rr < 62; ++rr) {
            const float a = bf2f(*(const LAS unsigned short*)(AT + (32 * th + rr) * 512 + c * 2));
#pragma unroll
            for (int i = 0; i < 32; ++i) { const int k = rr - i; if (k >= 0 && k < 31) out[i] += w[k] * a; }
        }
#pragma unroll
        for (int i = 0; i < 32; ++i) CV[(32 * th + i) * 256 + c] = out[i];
    }
    __syncthreads();
    {
        const f32x4 lg = *(const f32x4*)(inptr(I_ALG) + l * 256 + lane * 4), lb = *(const f32x4*)(inptr(I_ALB) + l * 256 + lane * 4);
        f32x4 v[8]; float sm[8];
#pragma unroll
        for (int j = 0; j < 8; ++j) { v[j] = *(const LAS f32x4*)(CV + (wave * 8 + j) * 256 + lane * 4); sm[j] = (v[j][0] + v[j][1]) + (v[j][2] + v[j][3]); }
#pragma unroll
        for (int o = 1; o < 64; o <<= 1)
#pragma unroll
            for (int j = 0; j < 8; ++j) sm[j] += __shfl_xor(sm[j], o);
#pragma unroll
        for (int j = 0; j < 8; ++j) { v[j] = v[j] - sm[j] * (1.f / 256.f); sm[j] = (v[j][0] * v[j][0] + v[j][1] * v[j][1]) + (v[j][2] * v[j][2] + v[j][3] * v[j][3]); }
#pragma unroll
        for (int o = 1; o < 64; o <<= 1)
#pragma unroll
            for (int j = 0; j < 8; ++j) sm[j] += __shfl_xor(sm[j], o);
#pragma unroll
        for (int j = 0; j < 8; ++j) {
            const float rs = rsqf_(sm[j] * (1.f / 256.f) + 1e-6f);
            f32x4 y = v[j] * rs * lg + lb;
            y[0] = siluf_(y[0]); y[1] = siluf_(y[1]); y[2] = siluf_(y[2]); y[3] = siluf_(y[3]);
            *(LAS v2u*)(ACT + (wave * 8 + j) * AB_ACTLD + lane * 8) = pack4(y);
        }
    }
    __syncthreads();
    const bf16* gw = (const bf16*)(ws + WS_SMALL + (size_t)l * 262144);
    const float* gb = inptr(I_APB) + l * 256;
    bf16x8 afr[2][8]; v2u zv[2][4];
#pragma unroll
    for (int nt2 = 0; nt2 < 2; ++nt2) {
#pragma unroll
        for (int ks = 0; ks < 8; ++ks) afr[nt2][ks] = *(const bf16x8*)(gw + (size_t)(32 * wave + 16 * nt2 + ln) * 256 + 32 * ks + 8 * gq);
#pragma unroll
        for (int tt = 0; tt < 4; ++tt) zv[nt2][tt] = *(const v2u*)(proj + (tok0 + 16 * tt + ln) * PLD + C_AZ + 32 * wave + 16 * nt2 + 4 * gq);
    }
#pragma unroll
    for (int nt2 = 0; nt2 < 2; ++nt2) {
        const int n0 = 32 * wave + 16 * nt2;
        f32x4 acc[4];
#pragma unroll
        for (int tt = 0; tt < 4; ++tt) acc[tt] = (f32x4){0.f, 0.f, 0.f, 0.f};
#pragma unroll
        for (int ks = 0; ks < 8; ++ks) {
#pragma unroll
            for (int tt = 0; tt < 4; ++tt) {
                const bf16x8 bfr = *(const LAS bf16x8*)(ACT + (16 * tt + ln) * AB_ACTLD + (32 * ks + 8 * gq) * 2);
                acc[tt] = MFMA16(afr[nt2][ks], bfr, acc[tt]);
            }
        }
        const f32x4 bias = *(const f32x4*)(gb + n0 + 4 * gq);
#pragma unroll
        for (int tt = 0; tt < 4; ++tt) {
            const int t = 16 * tt + ln; const int nn = n0 + 4 * gq;
            const v2u z = zv[nt2][tt];
            f32x4 o;
            o[0] = (acc[tt][0] + bias[0]) * siluf_(bflo(z.x)); o[1] = (acc[tt][1] + bias[1]) * siluf_(bfhi(z.x));
            o[2] = (acc[tt][2] + bias[2]) * siluf_(bflo(z.y)); o[3] = (acc[tt][3] + bias[3]) * siluf_(bfhi(z.y));
            *(v2u*)(mixed + (tok0 + t) * DM + nn) = pack4(o);
        }
    }
}

__device__ __forceinline__ void c_branch4(int l, unsigned char* ws, int bx, int tid, int nthr) {
    const bf16* proj = (const bf16*)(ws + WS_PROJ); bf16* mixed = (bf16*)(ws + WS_MIXED);
    const float* cw = inptr(I_CCW) + l * 768;
#pragma unroll 1
    for (int u = tid; u < 1024; u += nthr) {
        const int ci = bx + 64 * (u >> 8), tb = (u >> 5) & 7, c8 = u & 31;
        const size_t tokb = (size_t)ci * 64 + tb * 8;
        const bool first = ((ci & 63) == 0) && tb == 0;
        const bf16* p = proj + tokb * PLD + c8 * 8;
        v4u ra[10], rb[10], rc[8], rz[8];
#pragma unroll
        for (int r = 0; r < 10; ++r) {
            ra[r] = (v4u){0u, 0u, 0u, 0u}; rb[r] = (v4u){0u, 0u, 0u, 0u};
            if (r >= 2 || !first) { ra[r] = *(const v4u*)(p + (r - 2) * PLD + C_CC); rb[r] = *(const v4u*)(p + (r - 2) * PLD + C_CX); }
        }
#pragma unroll
        for (int r = 0; r < 8; ++r) { rc[r] = *(const v4u*)(p + r * PLD + C_CB); rz[r] = *(const v4u*)(p + r * PLD + C_CZ); }
        float w0[8], w1[8], w2[8];
        { const f32x4 a0 = *(const f32x4*)(cw + c8 * 8), a1 = *(const f32x4*)(cw + c8 * 8 + 4), b0 = *(const f32x4*)(cw + 256 + c8 * 8), b1 = *(const f32x4*)(cw + 256 + c8 * 8 + 4),
                      c0 = *(const f32x4*)(cw + 512 + c8 * 8), c1 = *(const f32x4*)(cw + 512 + c8 * 8 + 4);
#pragma unroll
          for (int e = 0; e < 4; ++e) { w0[e] = a0[e]; w0[4 + e] = a1[e]; w1[e] = b0[e]; w1[4 + e] = b1[e]; w2[e] = c0[e]; w2[4 + e] = c1[e]; } }
        float pm2[8], pm1[8], a[8], b[8];
        unpack8(ra[0], a); unpack8(rb[0], b);
#pragma unroll
        for (int e = 0; e < 8; ++e) pm2[e] = a[e] * b[e];
        unpack8(ra[1], a); unpack8(rb[1], b);
#pragma unroll
        for (int e = 0; e < 8; ++e) pm1[e] = a[e] * b[e];
#pragma unroll
        for (int r = 0; r < 8; ++r) {
            float p0[8], acc[8];
            unpack8(ra[r + 2], a); unpack8(rb[r + 2], b);
#pragma unroll
            for (int e = 0; e < 8; ++e) { p0[e] = a[e] * b[e]; acc[e] = w2[e] * p0[e] + w1[e] * pm1[e] + w0[e] * pm2[e]; }
            unpack8(rc[r], a); unpack8(rz[r], b);
            v4u w;
            w.x = pk2(a[0] * acc[0] * siluf_(b[0]), a[1] * acc[1] * siluf_(b[1])); w.y = pk2(a[2] * acc[2] * siluf_(b[2]), a[3] * acc[3] * siluf_(b[3]));
            w.z = pk2(a[4] * acc[4] * siluf_(b[4]), a[5] * acc[5] * siluf_(b[5])); w.w = pk2(a[6] * acc[6] * siluf_(b[6]), a[7] * acc[7] * siluf_(b[7]));
            *(v4u*)(mixed + (tokb + r) * DM + 512 + c8 * 8) = w;
#pragma unroll
            for (int e = 0; e < 8; ++e) { pm2[e] = pm1[e]; pm1[e] = p0[e]; }
        }
    }
}

__device__ __forceinline__ void ab_skinny(unsigned char* ws, const bf16* xb, const bf16* winT, LAS unsigned char* lds, int ci, int tid) {
    asm volatile("" : "+v"(tid));
    const int lane = tid & 63, wave = tid >> 6, gq = lane >> 4, ln = lane & 15;
    const bf16* ap = xb + (size_t)(ci * 64 + ln) * DM + 128 * wave + 8 * gq;
    const bf16* bp = winT + (size_t)(3328 + ln) * DM + 128 * wave + 8 * gq;
    f32x4 acc[4];
#pragma unroll
    for (int mt = 0; mt < 4; ++mt) acc[mt] = (f32x4){0.f, 0.f, 0.f, 0.f};
#pragma unroll
    for (int ks = 0; ks < 4; ++ks) {
        const bf16x8 bfr = *(const bf16x8*)(bp + 32 * ks);
#pragma unroll
        for (int mt = 0; mt < 4; ++mt) acc[mt] = MFMA16(*(const bf16x8*)(ap + (size_t)mt * 16 * DM + 32 * ks), bfr, acc[mt]);
    }
    __syncthreads();
    LAS f32x4* RED = (LAS f32x4*)lds;
#pragma unroll
    for (int mt = 0; mt < 4; ++mt) RED[(wave * 4 + mt) * 64 + lane] = acc[mt];
    __syncthreads();
    {
        const int token = tid >> 3, col = tid & 7, mt = token >> 4, row = token & 15, l2 = (row >> 2) * 16 + col, r = row & 3;
        float s = 0.f;
#pragma unroll
        for (int w = 0; w < 8; ++w) s += ((const LAS float*)(RED + (w * 4 + mt) * 64 + l2))[r];
        const size_t tok = (size_t)ci * 64 + token;
        const f32x4* pp = (const f32x4*)((const float*)(ws + WS_PART) + tok * 16);
        const f32x4 p0 = pp[0], p1 = pp[1], p2 = pp[2], p3 = pp[3];
        const float ss = ((p0[0] + p0[1]) + (p0[2] + p0[3])) + ((p1[0] + p1[1]) + (p1[2] + p1[3])) + ((p2[0] + p2[1]) + (p2[2] + p2[3])) + ((p3[0] + p3[1]) + (p3[2] + p3[3]));
        ((float*)(ws + WS_AB))[tok * 8 + col] = s * rsqf_(ss * (1.0f / 1024.0f) + 1e-6f);
    }
}
constexpr int DL_GATES = 69632, DL_WT = 73728, DL_SS = 76800;
__device__ __forceinline__ v4u pack8s(const float (&y)[8], float s) { v4u w; w.x = pk2(y[0] * s, y[1] * s); w.y = pk2(y[2] * s, y[3] * s); w.z = pk2(y[4] * s, y[5] * s); w.w = pk2(y[6] * s, y[7] * s); return w; }
__device__ __forceinline__ void dl_raw_load(const bf16* proj, int b, int h, int n0, int k, int tid, v4u (&r)[4]) {
    const int n = n0 + k; const size_t tokb = (size_t)b * SEQ + n * 64;
#pragma unroll
    for (int q = 0; q < 4; ++q) {
        const int id = tid + 512 * q;
        r[q] = (v4u){0u, 0u, 0u, 0u};
        if (id < 1608) {
            const int m = id / 536, r2 = id - m * 536, rr = r2 >> 3, c8 = r2 & 7;
            if (n > 0 || rr >= 3) r[q] = *(const v4u*)(proj + (tokb + rr - 3) * PLD + C_DQ + m * 256 + h * 64 + c8 * 8);
        }
    }
}
__device__ __forceinline__ void dl_raw_write(LAS unsigned char* RAW, int buf, int tid, const v4u (&r)[4]) {
#pragma unroll
    for (int q = 0; q < 4; ++q) {
        const int id = tid + 512 * q;
        if (id < 1608) {
            const int m = id / 536, r2 = id - m * 536, rr = r2 >> 3, c8 = r2 & 7;
            *(LAS v4u*)(RAW + buf * 25728 + m * 8576 + rr * 128 + ((c8 ^ (rr & 7)) << 4)) = r[q];
        }
    }
}
__device__ __forceinline__ void dl_conv8l(const LAS unsigned char* R, const LAS float* WTm, int i, int cc, float (&y)[8]) {
    float x0[8], x1[8], x2[8], x3[8];
    { const int r = i + 3; unpack8(*(const LAS v4u*)(R + r * 128 + ((cc ^ (r & 7)) << 4)), x0); }
    { const int r = i + 2; unpack8(*(const LAS v4u*)(R + r * 128 + ((cc ^ (r & 7)) << 4)), x1); }
    { const int r = i + 1; unpack8(*(const LAS v4u*)(R + r * 128 + ((cc ^ (r & 7)) << 4)), x2); }
    { const int r = i;     unpack8(*(const LAS v4u*)(R + r * 128 + ((cc ^ (r & 7)) << 4)), x3); }
#pragma unroll
    for (int hh = 0; hh < 2; ++hh) {
        const f32x4 wa = *(const LAS f32x4*)(WTm + cc * 8 + hh * 4), wb = *(const LAS f32x4*)(WTm + 64 + cc * 8 + hh * 4),
                    wc = *(const LAS f32x4*)(WTm + 128 + cc * 8 + hh * 4), wd = *(const LAS f32x4*)(WTm + 192 + cc * 8 + hh * 4);
#pragma unroll
        for (int e = 0; e < 4; ++e) { const int ee = hh * 4 + e; y[ee] = siluf_(wa[e] * x3[ee] + wb[e] * x2[ee] + wc[e] * x1[ee] + wd[e] * x0[ee]); }
    }
}
__device__ __forceinline__ void dn_local4(int l, unsigned char* ws, LAS unsigned char* lds, int grp, int tid) {
    asm volatile("" : "+v"(tid));
    const int lane = tid & 63, wave = __builtin_amdgcn_readfirstlane(tid >> 6), gq = lane >> 4, ln = lane & 15;
    const int bh = grp >> 4, b = bh >> 2, h = bh & 3, n0 = (grp & 15) * 4;
    const bf16* proj = (const bf16*)(ws + WS_PROJ); const float* ab = (const float*)(ws + WS_AB);
    LAS float* GC = (LAS float*)(lds + DL_GATES); LAS float* BE = GC + 256; LAS float* EG = GC + 512; LAS float* EK = GC + 768;
    LAS float* WT = (LAS float*)(lds + DL_WT); LAS float* SS = (LAS float*)(lds + DL_SS);
    __syncthreads();
    if (wave < 4) {
        const int k = wave; const size_t row = (size_t)b * SEQ + (n0 + k) * 64 + lane;
        const float Adec = expf(inptr(I_ALOG)[l * 4 + h]), dtbias = inptr(I_DTB)[l * 4 + h];
        const float alpha = ab[row * 8 + h], betal = ab[row * 8 + 4 + h];
        float gc = -Adec * softplusf_(alpha + dtbias);
#pragma unroll
        for (int o = 1; o < 64; o <<= 1) { const float t = __builtin_bit_cast(float, __builtin_amdgcn_ds_bpermute((lane - o) << 2, __builtin_bit_cast(int, gc))); if (lane >= o) gc += t; }
        const float glast = __builtin_bit_cast(float, __builtin_amdgcn_readlane(__builtin_bit_cast(int, gc), 63));
        GC[k * 64 + lane] = gc; BE[k * 64 + lane] = sigmoidf_(betal); EG[k * 64 + lane] = expf(gc); EK[k * 64 + lane] = expf(glast - gc);
        if (lane == 0) ((float*)(ws + WS_CTL + CTL_EGL))[bh * 64 + n0 + k] = expf(glast);
    } else if (wave < 7) {
        const int m = wave - 4; const float* cw = inptr(I_DCW) + l * 3072 + m * 256 + h * 64;
#pragma unroll
        for (int tap = 0; tap < 4; ++tap) WT[m * 256 + tap * 64 + lane] = cw[tap * 768 + lane];
    }
    __syncthreads();
    {
        const int cc = wave, i = lane;
        LAS unsigned char* RAW = lds;
        v4u rawr[4];
        dl_raw_load(proj, b, h, n0, 0, tid, rawr); dl_raw_write(RAW, 0, tid, rawr);
#pragma unroll 1
        for (int k = 0; k < 4; ++k) {
            const int n = n0 + k, buf = k & 1;
            unsigned char* scr = ws + WS_SCR + (size_t)(bh * 64 + n) * 40960;
            bf16* gKN = (bf16*)scr; bf16* gQD = (bf16*)(scr + 8192); bf16* gQN = (bf16*)(scr + 16384); bf16* gBKT = (bf16*)(scr + 24576); bf16* gBVT = (bf16*)(scr + 32768);
            bf16* gKDT = (bf16*)(ws + WS_MISC + MISC_BT) + (size_t)(bh * 64 + n) * 4096;
            LDS_WAIT(); __syncthreads();
            if (k + 1 < 4) dl_raw_load(proj, b, h, n0, k + 1, tid, rawr);
            float yq[8], yk[8], yv[8];
            dl_conv8l(RAW + buf * 25728, WT, i, cc, yq); dl_conv8l(RAW + buf * 25728 + 8576, WT + 256, i, cc, yk); dl_conv8l(RAW + buf * 25728 + 17152, WT + 512, i, cc, yv);
            float sq = 0.f, sk = 0.f;
#pragma unroll
            for (int e = 0; e < 8; ++e) { sq += yq[e] * yq[e]; sk += yk[e] * yk[e]; }
            SS[cc * 64 + i] = sq; SS[512 + cc * 64 + i] = sk;
            if (k + 1 < 4) dl_raw_write(RAW, buf ^ 1, tid, rawr);
            LDS_WAIT(); __syncthreads();
            float tq = 0.f, tk = 0.f;
#pragma unroll
            for (int c2 = 0; c2 < 8; ++c2) { tq += SS[c2 * 64 + i]; tk += SS[512 + c2 * 64 + i]; }
            const float scq = 0.125f * rsqf_(tq + 1e-6f), sck = rsqf_(tk + 1e-6f);
            const float be = BE[k * 64 + i], eg = EG[k * 64 + i], ek = EK[k * 64 + i];
            *(v4u*)(gQN + i * 64 + cc * 8) = pack8s(yq, scq);
            *(v4u*)(gQD + i * 64 + cc * 8) = pack8s(yq, scq * eg);
            *(v4u*)(gKN + i * 64 + cc * 8) = pack8s(yk, sck);
            const float sb = sck * be * eg, sd = sck * ek;
#pragma unroll
            for (int e = 0; e < 8; ++e) {
                gBKT[(cc * 8 + e) * 64 + i] = (bf16)f2bf(yk[e] * sb);
                gKDT[(cc * 8 + e) * 64 + i] = (bf16)f2bf(yk[e] * sd);
                gBVT[(cc * 8 + e) * 64 + i] = (bf16)f2bf(yv[e] * be);
            }
        }
    }
    VM_WAIT(); __syncthreads();
    const int k = wave >> 1, role = wave & 1, n = n0 + k;
    unsigned char* scr = ws + WS_SCR + (size_t)(bh * 64 + n) * 40960;
    bf16* gW = (bf16*)scr; bf16* gATT = (bf16*)(scr + 16384); bf16* gMN = (bf16*)(scr + 24576); bf16* gUT = (bf16*)(scr + 32768);
    bf16* gBT = (bf16*)(ws + WS_MISC + MISC_BT) + (size_t)(bh * 64 + n) * 4096;
    LAS float* LM = (LAS float*)(lds + k * 17408); LAS float* TM = LM; LAS unsigned char* GS = lds + k * 17408;
    const LAS float* GCk = GC + k * 64; const LAS float* BEk = BE + k * 64;
    const int foff = (ln * 64 + 8 * gq);
    {
        bf16x8 fk[4][2], fq[4][2];
#pragma unroll
        for (int t = 0; t < 4; ++t)
#pragma unroll
            for (int ks = 0; ks < 2; ++ks) { fk[t][ks] = *(const bf16x8*)(gW + foff + t * 1024 + ks * 32); if (role) fq[t][ks] = *(const bf16x8*)(gATT + foff + t * 1024 + ks * 32); else fq[t][ks] = fk[t][ks]; }
#pragma unroll
        for (int nt = 0; nt < 4; ++nt) {
            const int i = 16 * nt + ln; const float gci = GCk[i], bi = BEk[i];
#pragma unroll
            for (int mt = 0; mt < 4; ++mt) {
                if (mt <= nt) {
                    f32x4 a = (f32x4){0.f, 0.f, 0.f, 0.f};
#pragma unroll
                    for (int ks = 0; ks < 2; ++ks) a = MFMA16(fk[mt][ks], fq[nt][ks], a);
                    const f32x4 gcj = *(const LAS f32x4*)(GCk + 16 * mt + 4 * gq);
                    f32x4 o;
#pragma unroll
                    for (int r = 0; r < 4; ++r) { const int j = 16 * mt + 4 * gq + r; const float dec = (j <= i) ? __expf(gci - gcj[r]) : 0.f;
                        o[r] = role ? a[r] * dec : ((j < i) ? bi * a[r] * dec : 0.f); }
                    if (role) *(v2u*)(gATT + i * 64 + 16 * mt + 4 * gq) = pack4(o);
                    else *(LAS f32x4*)(LM + i * 68 + 16 * mt + 4 * gq) = o;
                } else if (role) {
                    unsigned zz; asm volatile("v_mov_b32 %0, 0" : "=v"(zz));
                    *(v2u*)(gATT + i * 64 + 16 * mt + 4 * gq) = (v2u){zz, zz};
                }
            }
        }
    }
    LDS_WAIT(); __syncthreads();
    if (role == 0) {
        const int c = lane;
#pragma unroll 1
        for (int bi = 0; bi < 4; ++bi) {
            float acc[16];
#pragma unroll
            for (int ii = 0; ii < 16; ++ii) acc[ii] = (16 * bi + ii == c) ? 1.f : 0.f;
#pragma unroll 1
            for (int bj = 0; bj < bi; ++bj) {
                float tj[16];
#pragma unroll
                for (int jj = 0; jj < 16; ++jj) tj[jj] = TM[(16 * bj + jj) * 68 + c];
#pragma unroll
                for (int ii = 0; ii < 16; ++ii) {
                    const LAS f32x4* lp = (const LAS f32x4*)(LM + (16 * bi + ii) * 68 + 16 * bj);
                    const f32x4 l0 = lp[0], l1 = lp[1], l2 = lp[2], l3 = lp[3];
                    float s2 = 0.f;
#pragma unroll
                    for (int e = 0; e < 4; ++e) { s2 += l0[e] * tj[e]; s2 += l1[e] * tj[4 + e]; s2 += l2[e] * tj[8 + e]; s2 += l3[e] * tj[12 + e]; }
                    acc[ii] -= s2;
                }
            }
#pragma unroll
            for (int ii = 1; ii < 16; ++ii) {
                const LAS f32x4* lp = (const LAS f32x4*)(LM + (16 * bi + ii) * 68 + 16 * bi);
                float lrow[16];
#pragma unroll
                for (int q = 0; q < 4; ++q) { if (4 * q < ii) { const f32x4 t = lp[q]; lrow[4 * q] = t[0]; lrow[4 * q + 1] = t[1]; lrow[4 * q + 2] = t[2]; lrow[4 * q + 3] = t[3]; } }
                float s2 = 0.f;
#pragma unroll
                for (int jj = 0; jj + 1 < ii; ++jj) s2 += lrow[jj] * acc[jj];
                acc[ii] = (acc[ii] - s2) - lrow[ii - 1] * acc[ii - 1];
            }
            LDS_WAIT();
#pragma unroll
            for (int ii = 0; ii < 16; ++ii) TM[(16 * bi + ii) * 68 + c] = acc[ii];
            LDS_WAIT();
        }
    } else {
        s5_xloc(l, ws, grp, 2 * k, lane); s5_xloc(l, ws, grp, 2 * k + 1, lane);
    }
    __syncthreads();
    bf16x8 fA_[4][2], fB_[4][2], fv[4][2], fb[4][2];
#pragma unroll
    for (int t = 0; t < 4; ++t)
#pragma unroll
        for (int ks = 0; ks < 2; ++ks) {
            fv[t][ks] = *(const bf16x8*)(gUT + foff + t * 1024 + ks * 32);
            fb[t][ks] = *(const bf16x8*)(gMN + foff + t * 1024 + ks * 32);
            if (role == 0) { const LAS f32x4* tp = (const LAS f32x4*)(TM + (16 * t + ln) * 68 + 32 * ks + 8 * gq); fA_[t][ks] = pack8(tp[0], tp[1]); fB_[t][ks] = fA_[t][ks]; }
            else { fA_[t][ks] = *(const bf16x8*)(gBT + foff + t * 1024 + ks * 32);
                float tv[8];
#pragma unroll
                for (int e = 0; e < 8; ++e) tv[e] = TM[(32 * ks + 8 * gq + e) * 68 + 16 * t + ln];
                v4u w; w.x = pk2(tv[0], tv[1]); w.y = pk2(tv[2], tv[3]); w.z = pk2(tv[4], tv[5]); w.w = pk2(tv[6], tv[7]); fB_[t][ks] = __builtin_bit_cast(bf16x8, w); }
        }
    asm volatile("s_waitcnt vmcnt(0) lgkmcnt(0)" ::: "memory"); __syncthreads();
    if (role == 0) {
#pragma unroll
        for (int nt = 0; nt < 4; ++nt)
#pragma unroll
            for (int mt = 0; mt < 4; ++mt) {
                f32x4 au = (f32x4){0.f, 0.f, 0.f, 0.f}, aw = (f32x4){0.f, 0.f, 0.f, 0.f};
#pragma unroll
                for (int ks = 0; ks < 2; ++ks) { au = MFMA16(fA_[mt][ks], fv[nt][ks], au); aw = MFMA16(fb[nt][ks], fA_[mt][ks], aw); }
                *(v2u*)(gUT + (16 * nt + ln) * 64 + 16 * mt + 4 * gq) = pack4(au);
                *(v2u*)(gW + (16 * mt + ln) * 64 + 16 * nt + 4 * gq) = pack4(aw);
            }
    } else {
        f32x4 ag[4][4];
#pragma unroll
        for (int nt = 0; nt < 4; ++nt)
#pragma unroll
            for (int mt = 0; mt < 4; ++mt) {
                f32x4 a = (f32x4){0.f, 0.f, 0.f, 0.f};
#pragma unroll
                for (int ks = 0; ks < 2; ++ks) a = MFMA16(fA_[mt][ks], fB_[nt][ks], a);
                ag[mt][nt] = a;
            }
#pragma unroll
        for (int mt = 0; mt < 4; ++mt)
#pragma unroll
            for (int nt = 0; nt < 4; ++nt)
#pragma unroll
                for (int r = 0; r < 4; ++r) *(LAS unsigned short*)(GS + (16 * mt + 4 * gq + r) * 144 + (16 * nt + ln) * 2) = (unsigned short)f2bf(ag[mt][nt][r]);
        LDS_WAIT();
        bf16x8 fg[4][2];
#pragma unroll
        for (int t = 0; t < 4; ++t)
#pragma unroll
            for (int ks = 0; ks < 2; ++ks) fg[t][ks] = *(const LAS bf16x8*)(GS + (16 * t + ln) * 144 + (32 * ks + 8 * gq) * 2);
#pragma unroll
        for (int nt = 0; nt < 4; ++nt)
#pragma unroll
            for (int mt = 0; mt < 4; ++mt) {
                f32x4 ab2 = (f32x4){0.f, 0.f, 0.f, 0.f}, am = (f32x4){0.f, 0.f, 0.f, 0.f};
#pragma unroll
                for (int ks = 0; ks < 2; ++ks) { ab2 = MFMA16(fg[mt][ks], fv[nt][ks], ab2); am = MFMA16(fb[nt][ks], fg[mt][ks], am); }
                *(v2u*)(gBT + (16 * nt + ln) * 64 + 16 * mt + 4 * gq) = pack4(ab2);
                *(v2u*)(gMN + (16 * mt + ln) * 64 + 32 * (nt >> 1) + 8 * gq + 4 * (nt & 1)) = pack4(-am);
            }
    }
    LDS_WAIT();
}

__device__ __forceinline__ void dn_chain3(unsigned char* ws, LAS unsigned char* wl, int cidx, int lane) {
    const int bh = cidx >> 2, sv = cidx & 3;
    const int gq = lane >> 4, ln = lane & 15;
    f32x4 S[4];
#pragma unroll
    for (int t = 0; t < 4; ++t) S[t] = (f32x4){0.f, 0.f, 0.f, 0.f};
    const float eglv = ((const float*)(ws + WS_CTL + CTL_EGL))[bh * 64 + lane];
    const unsigned char* mbase = ws + WS_SCR + (size_t)(bh * 64) * 40960 + 24576 + (ln * 64 + 8 * gq) * 2;
    const unsigned char* bbase = ws + WS_MISC + MISC_BT + (size_t)(bh * 64) * 8192 + ((16 * sv + ln) * 64 + 4 * gq) * 2;
    unsigned char* spbase = ws + WS_MISC + MISC_SP + (size_t)(bh * 64) * 8192 + ((16 * sv + ln) * 64 + 4 * gq) * 2;
#pragma unroll
    for (int dt = 0; dt < 4; ++dt) *(v2u*)(spbase + dt * 32) = (v2u){0u, 0u};
    bf16x8 fM[4][4][2]; v2u fB[4][4];
#pragma unroll
    for (int j = 0; j < 4; ++j)
#pragma unroll
        for (int dt = 0; dt < 4; ++dt) {
#pragma unroll
            for (int ks = 0; ks < 2; ++ks) fM[j][dt][ks] = *(const bf16x8*)(mbase + (size_t)j * 40960 + dt * 2048 + ks * 64);
            fB[j][dt] = *(const v2u*)(bbase + (size_t)j * 8192 + dt * 32);
        }
#pragma unroll 1
    for (int n0 = 0; n0 < 64; n0 += 4) {
#pragma unroll
        for (int j = 0; j < 4; ++j) {
            const int n = n0 + j;
            const float eg = __shfl(eglv, n);
            bf16x8 sf[2];
            sf[0] = pack8(S[0], S[1]); sf[1] = pack8(S[2], S[3]);
            f32x4 Sn[4];
#pragma unroll
            for (int dt = 0; dt < 4; ++dt) {
                const v2u bb = fB[j][dt];
                f32x4 a = S[dt] * eg + (f32x4){bflo(bb.x), bfhi(bb.x), bflo(bb.y), bfhi(bb.y)};
#pragma unroll
                for (int ks = 0; ks < 2; ++ks) a = MFMA16(fM[j][dt][ks], sf[ks], a);
                Sn[dt] = a;
            }
#pragma unroll
            for (int dt = 0; dt < 4; ++dt) S[dt] = Sn[dt];
            const int np = (n + 4 < 64) ? n + 4 : 63;
#pragma unroll
            for (int dt = 0; dt < 4; ++dt) {
#pragma unroll
                for (int ks = 0; ks < 2; ++ks) fM[j][dt][ks] = *(const bf16x8*)(mbase + (size_t)np * 40960 + dt * 2048 + ks * 64);
                fB[j][dt] = *(const v2u*)(bbase + (size_t)np * 8192 + dt * 32);
            }
            if (n + 1 < 64) {
#pragma unroll
                for (int dt = 0; dt < 4; ++dt) *(v2u*)(spbase + (size_t)(n + 1) * 8192 + dt * 32) = pack4(S[dt]);
            }
        }
    }
}

__device__ __forceinline__ void dn_out2(int l, unsigned char* ws, LAS unsigned char* VT, LAS float* SSX, int item, int k, int role, int lane) {
    asm volatile("" : "+v"(lane));
    const int b = item >> 8, h = (item >> 6) & 3, n = item & 63;
    const int gq = lane >> 4, ln = lane & 15;
    const bf16* proj = (const bf16*)(ws + WS_PROJ); bf16* mixed = (bf16*)(ws + WS_MIXED);
    const size_t tok0 = (size_t)b * SEQ + n * 64;
    const unsigned char* base = ws + WS_SCR + (size_t)item * 40960;
    const unsigned char* sp = ws + WS_MISC + MISC_SP + (size_t)item * 8192;
    const int foff = (ln * 64 + 8 * gq) * 2;
    bf16x8 fW[4][2], fQ[4][2], fA[4][2];
#pragma unroll
    for (int t = 0; t < 4; ++t)
#pragma unroll
        for (int ks = 0; ks < 2; ++ks) {
            fW[t][ks] = *(const bf16x8*)(base + foff + t * 2048 + ks * 64);
            fQ[t][ks] = *(const bf16x8*)(base + 8192 + foff + t * 2048 + ks * 64);
            fA[t][ks] = *(const bf16x8*)(base + 16384 + foff + t * 2048 + ks * 64);
        }
    bf16x8 sf[2][2]; v2u uu[2][4], zv[2][4];
#pragma unroll
    for (int s2 = 0; s2 < 2; ++s2) {
        const int sv = 2 * role + s2;
#pragma unroll
        for (int ks = 0; ks < 2; ++ks) sf[s2][ks] = *(const bf16x8*)(sp + ((16 * sv + ln) * 64 + 32 * ks + 8 * gq) * 2);
#pragma unroll
        for (int mt = 0; mt < 4; ++mt) {
            uu[s2][mt] = *(const v2u*)(base + 32768 + ((16 * sv + ln) * 64 + 16 * mt + 4 * gq) * 2);
            zv[s2][mt] = *(const v2u*)(proj + (tok0 + 16 * mt + ln) * PLD + C_DZ + h * 64 + 16 * sv + 4 * gq);
        }
    }
    f32x4 o[2][4];
#pragma unroll
    for (int s2 = 0; s2 < 2; ++s2) {
#pragma unroll
        for (int mt = 0; mt < 4; ++mt) {
            f32x4 a = (f32x4){0.f, 0.f, 0.f, 0.f};
#pragma unroll
            for (int ks = 0; ks < 2; ++ks) a = MFMA16(fW[mt][ks], sf[s2][ks], a);
            const v2u u2 = uu[s2][mt];
            const f32x4 vn = (f32x4){bflo(u2.x) - a[0], bfhi(u2.x) - a[1], bflo(u2.y) - a[2], bfhi(u2.y) - a[3]};
            *(LAS v2u*)(VT + ln * 144 + (16 * mt + 4 * gq) * 2) = pack4(vn);
        }
        LDS_WAIT();
        bf16x8 vf[2];
#pragma unroll
        for (int ks = 0; ks < 2; ++ks) vf[ks] = *(const LAS bf16x8*)(VT + ln * 144 + (32 * ks + 8 * gq) * 2);
#pragma unroll
        for (int nt = 0; nt < 4; ++nt) {
            f32x4 a = (f32x4){0.f, 0.f, 0.f, 0.f};
#pragma unroll
            for (int ks = 0; ks < 2; ++ks) a = MFMA16(sf[s2][ks], fQ[nt][ks], a);
#pragma unroll
            for (int ks = 0; ks < 2; ++ks) a = MFMA16(vf[ks], fA[nt][ks], a);
            o[s2][nt] = a;
        }
        LDS_WAIT();
    }
    float ss[4];
#pragma unroll
    for (int nt = 0; nt < 4; ++nt) {
        float t = 0.f;
#pragma unroll
        for (int s2 = 0; s2 < 2; ++s2) t += (o[s2][nt][0] * o[s2][nt][0] + o[s2][nt][1] * o[s2][nt][1]) + (o[s2][nt][2] * o[s2][nt][2] + o[s2][nt][3] * o[s2][nt][3]);
        ss[nt] = t;
    }
#pragma unroll
    for (int nt = 0; nt < 4; ++nt) ss[nt] += __shfl_xor(ss[nt], 16);
#pragma unroll
    for (int nt = 0; nt < 4; ++nt) ss[nt] += __shfl_xor(ss[nt], 32);
    if (gq == 0) {
#pragma unroll
        for (int nt = 0; nt < 4; ++nt) SSX[((k * 2 + role) * 4 + nt) * 16 + ln] = ss[nt];
    }
    LDS_WAIT(); __syncthreads();
    const float* ng = inptr(I_DNG) + l * 64;
#pragma unroll
    for (int nt = 0; nt < 4; ++nt) {
        const float tot = ss[nt] + SSX[((k * 2 + (role ^ 1)) * 4 + nt) * 16 + ln];
        const float rs = rsqf_(tot * (1.f / 64.f) + 1e-6f);
        const size_t row = tok0 + 16 * nt + ln;
#pragma unroll
        for (int s2 = 0; s2 < 2; ++s2) {
            const int v0 = 16 * (2 * role + s2) + 4 * gq;
            const f32x4 g4 = *(const f32x4*)(ng + v0);
            const v2u z = zv[s2][nt];
            f32x4 r;
            r[0] = o[s2][nt][0] * rs * g4[0] * siluf_(bflo(z.x)); r[1] = o[s2][nt][1] * rs * g4[1] * siluf_(bfhi(z.x));
            r[2] = o[s2][nt][2] * rs * g4[2] * siluf_(bflo(z.y)); r[3] = o[s2][nt][3] * rs * g4[3] * siluf_(bfhi(z.y));
            *(v2u*)(mixed + row * DM + 768 + h * 64 + v0) = pack4(r);
        }
    }
}
constexpr int PH_FINAL = 1 + 8 * DEPTH, PH_END = PH_FINAL + 1;
__global__ void __launch_bounds__(NWAVES * 64, 2) mk_kernel(Args args) {
    extern __shared__ __attribute__((aligned(16))) unsigned char lds_raw[];
    LAS unsigned char* lds = (LAS unsigned char*)lds_raw;
    volatile LAS unsigned* MISC = (volatile LAS unsigned*)(lds + MISC_OFF);
    const int tid = threadIdx.x, lane = tid & 63, wave = __builtin_amdgcn_readfirstlane(tid >> 6);
    const int G = gridDim.x; const int bx = blockIdx.x;
    const int vcu = (G % 8 == 0) ? (bx % 8) * (G / 8) + bx / 8 : bx;
    const int gw = vcu * NWAVES + wave, NGW = G * NWAVES;
    unsigned char* ws0 = args.ws;
    for (int u = tid; u < (LDS_BYTES - LDSCTL_OFF) / 4; u += NWAVES * 64) ((LAS unsigned*)(lds + LDSCTL_OFF))[u] = 0u;
    __syncthreads();
    const int lo = args.ph_lo, hi = args.ph_hi;
    XcdBarrier bar; bar.bar = (unsigned*)(ws0 + WS_CTL) + CW_BAR; bar.x = 0; bar.st = nullptr;
    if (hi - lo > 1) bar = xcd_barrier_post((unsigned*)(ws0 + WS_CTL) + CW_BAR, MISC + 8);
    bool need_bar = false;
#define IN(k) (lo <= (k) && (k) < hi)
#define PH_BEGIN(k) if (IN(k)) { if (need_bar) xcd_barrier(bar); need_bar = true;
#define PH_END_ }

    PH_BEGIN(0)
        for (int it = vcu; it < 256; it += G) s5_tables(ws0, lds, it, tid);
        __syncthreads();
        phase_prologue(args, ws0, lds, gw, NGW, wave, lane);
        __syncthreads();
    PH_END_
#pragma nounroll
    for (int l_ = 0; l_ < DEPTH; ++l_) {
        int l = l_; asm volatile("" : "+s"(l));
        unsigned ones_ = ~0u; asm volatile("" : "+s"(ones_));
        int tid2 = wave * 64 + (int)__builtin_amdgcn_mbcnt_hi(ones_, __builtin_amdgcn_mbcnt_lo(ones_, 0u)); asm volatile("" : "+v"(tid2)); const int lane2 = tid2 & 63;
        GAS unsigned char* wsg_ = (GAS unsigned char*)ws0; asm volatile("" : "+s"(wsg_)); unsigned char* ws = (unsigned char*)wsg_;
        GAS float* outg_ = (GAS float*)args.out; asm volatile("" : "+s"(outg_)); float* outp = (float*)outg_;
        const bf16* proj = (const bf16*)(ws + WS_PROJ); bf16* mixed = (bf16*)(ws + WS_MIXED); const float* ab = (const float*)(ws + WS_AB);
        const int pb = 1 + 8 * l;
        PH_BEGIN(pb)
            {
            pg8::Gemm g{(const pg8::bf16_t*)outp, (const pg8::bf16_t*)(ws + WS_WIN + l * WIN_BYTES), MTOK, 3072, DM};
            pg8::StaticOrder S; S.init(MTOK, 3072, G, bx);
            pg8::EpiInProj E{(pg8::bf16_t*)(ws + WS_PROJ), (const float*)(ws + WS_PART), 0};
            pg8::gemm_phase<pg8::EpiInProj, pg8::StaticOrder, true, true>(lds, g, S, E, tid2);
            }
            for (int it = vcu; it < 256; it += G) ab_skinny(ws, (const bf16*)outp, (const bf16*)(ws + WS_WIN + l * WIN_BYTES), lds, it, tid2);
        PH_END_
        PH_BEGIN(pb + 1)
            { for (int it = vcu; it < 256; it += G) dn_local4(l, ws, lds, it, tid2); }
            __syncthreads();
        PH_END_
        PH_BEGIN(pb + 2)
            if (bx < 64) {
                if (wave == 0) dn_chain3(ws, lds, bx, lane2);
                else {
                    c_branch4(l, ws, bx, tid2 - 64, 448);
                    if (bx < 16 && wave <= 4) s5_scan(l, ws, bx * 256 + (tid2 - 64));
                }
            }
            else if (bx < 128) {
                pg8::Gemm g{(const pg8::bf16_t*)outp, (const pg8::bf16_t*)(ws + WS_WIN + l * WIN_BYTES) + (size_t)3072 * DM, MTOK, 256, DM};
                pg8::StaticOrder S; S.init(MTOK, 256, 64, bx - 64);
                pg8::EpiInProj E{(pg8::bf16_t*)(ws + WS_PROJ), (const float*)(ws + WS_PART), 3072};
                pg8::gemm_phase<pg8::EpiInProj, pg8::StaticOrder, true, true>(lds, g, S, E, tid2);
            }
            else {
                int bxl = bx; asm volatile("" : "+s"(bxl));
                for (int it = bxl - 128; it < 256; it += (G - 128)) a_branch(l, ws, lds, it, tid2);
            }
        PH_END_
        PH_BEGIN(pb + 3)
            { for (int it = (wave >> 1) * G + vcu; it < 1024; it += 4 * G) dn_out2(l, ws, lds + 102400 + wave * 2304, (LAS float*)(lds + 122880), it, wave >> 1, wave & 1, lane2); }
            { for (int it = vcu; it < 256; it += G) s5_out(l, ws, lds, it, wave, lane2); }
        PH_END_
        PH_BEGIN(pb + 7)
            pg8::Gemm g{(const pg8::bf16_t*)(ws + WS_MIXED), (const pg8::bf16_t*)(ws + WS_WOUT + (size_t)l * 2 * MiB), MTOK, DM, DM};
            pg8::StaticOrder S; S.init(MTOK, DM, G, bx);
            pg8::EpiOutProj E{(pg8::bf16_t*)outp, (pg8::bf16_t*)(ws + WS_PROJ), (float*)(ws + WS_PART), l == DEPTH - 1};
            pg8::gemm_phase<pg8::EpiOutProj, pg8::StaticOrder, true, true>(lds, g, S, E, tid2);
        PH_END_
    }
    PH_BEGIN(PH_FINAL) { unsigned ones2_ = ~0u; asm volatile("" : "+s"(ones2_)); int tf = wave * 64 + (int)__builtin_amdgcn_mbcnt_hi(ones2_, __builtin_amdgcn_mbcnt_lo(ones2_, 0u)); asm volatile("" : "+v"(tf)); phase_final_norm(args, (const bf16*)(ws0 + WS_PROJ), vcu * NWAVES + (tf >> 6), NGW, tf & 63); } PH_END_
#undef IN
#undef PH_BEGIN
#undef PH_END_
}

extern "C" void kernel_launch(void* const* d_in, const int* in_sizes, int n_in, void* d_out, int out_size, void* d_ws, size_t ws_size, hipStream_t stream) {
    static int grid = 0;
    if (grid == 0) {
        if (n_in != 26 || in_sizes[0] != MTOK * DM || out_size != MTOK * DM || ws_size < WS_END) { fprintf(stderr, "kernel_launch: unexpected shapes (n_in %d, in0 %d, out %d, ws %zu)\n", n_in, n_in > 0 ? in_sizes[0] : -1, out_size, ws_size); grid = -1; return; }
        int dev = 0, cus = 0, per_cu = 0;
        if (hipGetDevice(&dev) != hipSuccess || hipDeviceGetAttribute(&cus, hipDeviceAttributeMultiprocessorCount, dev) != hipSuccess) { grid = -1; return; }
        if (hipFuncSetAttribute((const void*)mk_kernel, hipFuncAttributeMaxDynamicSharedMemorySize, LDS_BYTES) != hipSuccess) { fprintf(stderr, "kernel_launch: hipFuncSetAttribute failed\n"); grid = -1; return; }
        if (hipOccupancyMaxActiveBlocksPerMultiprocessor(&per_cu, (const void*)mk_kernel, NWAVES * 64, LDS_BYTES) != hipSuccess || per_cu < 1) { fprintf(stderr, "kernel_launch: occupancy query says %d blocks per CU\n", per_cu); (void)hipGetLastError(); grid = -1; return; }
        grid = cus;
        if (grid != 256) { fprintf(stderr, "kernel_launch: built for a 256-CU device (got %d)\n", grid); grid = -1; return; }
    }
    if (grid < 0) return;
    (void)hipMemsetAsync((char*)d_ws + WS_CTL, 0, CTL_ZERO_BYTES, stream);
    Args a{};
    for (int i = 0; i < 26; ++i) a.in[i] = (const float*)d_in[i];
    a.out = (float*)d_out; a.ws = (unsigned char*)d_ws;
    a.ph_lo = 0; a.ph_hi = PH_END;
    void* kargs[] = {(void*)&a};
    hipError_t e = hipLaunchCooperativeKernel((const void*)mk_kernel, dim3(grid), dim3(NWAVES * 64), kargs, LDS_BYTES, stream);
    if (e != hipSuccess) fprintf(stderr, "kernel_launch: cooperative launch failed: %s (grid %d)\n", hipGetErrorString(e), grid);
}
```

```cpp
#include <hip/hip_runtime.h>
#include <cstdio>
#include <cstdint>
namespace pg8 {
#define PG8_LAS __attribute__((address_space(3)))
typedef unsigned short bf16_t;
typedef short bf16x8 __attribute__((ext_vector_type(8)));
typedef float f32x4 __attribute__((ext_vector_type(4)));
typedef unsigned u32x4 __attribute__((ext_vector_type(4)));
constexpr int BM = 256, BK = 64, HALF = 128, HTB = HALF * BK * 2  , STAGE_BYTES = 8 * HTB, NXCD = 8, WGM = 8;

__host__ __device__ __forceinline__ int lds_byte(int r, int c) { const int st = (r >> 4) * 2 + (c >> 5), rr = r & 15, cc = c & 31, ob = rr * 64 + cc * 2; return st * 1024 + (ob ^ (((ob >> 9) & 1) << 5)); }
__host__ __device__ __forceinline__ void stage_rc(int b, int& R, int& C) { const int st = b / 1024, sb = b % 1024, swz = sb ^ (((sb >> 9) & 1) << 5); R = (st >> 1) * 16 + swz / 64; C = (st & 1) * 32 + (swz % 64) / 2; }
__host__ __device__ __forceinline__ int perm32(int rho) { const int n = rho >> 4, i = rho & 15; return 8 * (i >> 2) + 4 * n + (i & 3); }

struct Unit { int pm, pn; };
struct Gemm { const bf16_t* A; const bf16_t* Bt; int M, N, K; };

struct StaticOrder {
    int nM, nN, nwg, G, c;
    __host__ __device__ void init(int M, int N, int G_, int c_) { nM = M / BM; nN = N / BM; nwg = nM * nN; G = G_; c = c_; }
    __host__ __device__ bool next(int i, Unit& u) const {
        const long L = (long)i * G + c; if (L >= nwg) return false;
        int wgid = (int)L; { const int q = nwg / NXCD, r = nwg % NXCD, xcd = wgid % NXCD, off = wgid / NXCD; wgid = (xcd < r ? xcd * (q + 1) : r * (q + 1) + (xcd - r) * q) + off; }
        const int nig = WGM * nN, gid = wgid / nig, fm = gid * WGM, gsz = (nM - fm) < WGM ? (nM - fm) : WGM;
        u.pm = fm + ((wgid % nig) % gsz); u.pn = (wgid % nig) / gsz; return true;
    }
    __device__ __forceinline__ void a_ready(const Unit&) const {}
    __device__ __forceinline__ void done(const Unit&) const {}
};

__device__ __forceinline__ unsigned cvt_pk_bf16(float lo, float hi) { unsigned r; asm volatile("v_cvt_pk_bf16_f32 %0, %1, %2" : "=v"(r) : "v"(lo), "v"(hi)); return r; }
typedef unsigned u32x2 __attribute__((ext_vector_type(2)));

struct EpiInProj {
    static constexpr bool PERM = true, AFTER_DRAIN = false;
    bf16_t* P; const float* part; int cofs;
    __device__ __forceinline__ void operator()(const f32x4 (&acc)[2][2][4][2], const Unit& u, int wr, int wc, int fr, int fq) const {
        const int row0 = u.pm * BM + wr * 64 + fr;
        const int col0 = cofs + u.pn * BM + wc * 32 + 8 * fq;
        f32x4 pr[2][4]; float rs_[2][4];
#pragma unroll
        for (int ai = 0; ai < 2; ++ai)
#pragma unroll
            for (int m = 0; m < 4; ++m) pr[ai][m] = *(const f32x4*)(part + (size_t)(row0 + ai * HALF + m * 16) * 16 + 4 * fq);
#pragma unroll
        for (int ai = 0; ai < 2; ++ai)
#pragma unroll
            for (int m = 0; m < 4; ++m) { float s_ = (pr[ai][m][0] + pr[ai][m][1]) + (pr[ai][m][2] + pr[ai][m][3]); s_ += __shfl_xor(s_, 16); s_ += __shfl_xor(s_, 32);
                rs_[ai][m] = __builtin_amdgcn_rsqf(s_ * (1.0f / 1024.0f) + 1e-6f); }
#pragma unroll
        for (int ai = 0; ai < 2; ++ai)
#pragma unroll
            for (int m = 0; m < 4; ++m) {
                const int row = row0 + ai * HALF + m * 16;
                const float rstd = rs_[ai][m];
                {
                    bf16_t* rowp = P + (size_t)row * 3328 + col0;
#pragma unroll
                    for (int bj = 0; bj < 2; ++bj) { const f32x4 v0 = acc[ai][bj][m][0] * rstd, v1 = acc[ai][bj][m][1] * rstd;
                        u32x4 w; w.x = cvt_pk_bf16(v0[0], v0[1]); w.y = cvt_pk_bf16(v0[2], v0[3]); w.z = cvt_pk_bf16(v1[0], v1[1]); w.w = cvt_pk_bf16(v1[2], v1[3]);
                        *(u32x4*)(rowp + bj * HALF) = w; }
                }
            }
    }
};

struct EpiOutProj {
    static constexpr bool PERM = true, AFTER_DRAIN = false;
    bf16_t* xb; bf16_t* xb2; float* part; int last;
    __device__ __forceinline__ void operator()(const f32x4 (&acc)[2][2][4][2], const Unit& u, int wr, int wc, int fr, int fq) const {
        const int row0 = u.pm * BM + wr * 64 + fr, col0 = u.pn * BM + wc * 32 + 8 * fq;
#pragma unroll
        for (int ai = 0; ai < 2; ++ai) {
        u32x4 xo[2][4][2];
#pragma unroll
            for (int m = 0; m < 4; ++m)
#pragma unroll
                for (int bj = 0; bj < 2; ++bj) xo[ai][m][bj] = *(const u32x4*)(xb + (size_t)(row0 + ai * HALF + m * 16) * 1024 + col0 + bj * HALF);
#pragma unroll
            for (int m = 0; m < 4; ++m) {
                const int row = row0 + ai * HALF + m * 16;
                float ss = 0.f;
#pragma unroll
                for (int bj = 0; bj < 2; ++bj) {
                    const size_t off = (size_t)row * 1024 + col0 + bj * HALF;
                    const u32x4 x4 = xo[ai][m][bj];
                    f32x4 v0 = acc[ai][bj][m][0], v1 = acc[ai][bj][m][1];
                    v0[0] += __builtin_bit_cast(float, x4.x << 16); v0[1] += __builtin_bit_cast(float, x4.x & 0xffff0000u);
                    v0[2] += __builtin_bit_cast(float, x4.y << 16); v0[3] += __builtin_bit_cast(float, x4.y & 0xffff0000u);
                    v1[0] += __builtin_bit_cast(float, x4.z << 16); v1[1] += __builtin_bit_cast(float, x4.z & 0xffff0000u);
                    v1[2] += __builtin_bit_cast(float, x4.w << 16); v1[3] += __builtin_bit_cast(float, x4.w & 0xffff0000u);
                    ss += ((v0[0] * v0[0] + v0[1] * v0[1]) + (v0[2] * v0[2] + v0[3] * v0[3])) + ((v1[0] * v1[0] + v1[1] * v1[1]) + (v1[2] * v1[2] + v1[3] * v1[3]));
                    { u32x4 w; w.x = cvt_pk_bf16(v0[0], v0[1]); w.y = cvt_pk_bf16(v0[2], v0[3]); w.z = cvt_pk_bf16(v1[0], v1[1]); w.w = cvt_pk_bf16(v1[2], v1[3]); *(u32x4*)((last ? xb2 : xb) + off) = w; }
                }
                ss += __shfl_xor(ss, 16); ss += __shfl_xor(ss, 32);
                if (fq == 0) part[(size_t)row * 16 + u.pn * 4 + wc] = ss;
            }
        }
    }
};

template <class Epi, class Sched, bool ALIGN_EPI = false, bool SP2 = false>
__device__ __forceinline__ void gemm_phase(PG8_LAS unsigned char* lds, const Gemm g, const Sched& S, const Epi& E, int tid_in) {
    int tid_ = tid_in; asm volatile("" : "+v"(tid_));
    const int tid = tid_, wid = __builtin_amdgcn_readfirstlane(tid >> 6), lane = tid & 63, wr = wid >> 2, wc = wid & 3, fr = lane & 15, fq = lane >> 4;
    const int K = g.K, nt = K / BK;
    unsigned voffA[2], voffB[2];
#pragma unroll
    for (int i = 0; i < 2; ++i) { int R, C; stage_rc(tid * 16 + i * 8192, R, C); const int Rb = Epi::PERM ? ((R & ~31) + perm32(R & 31)) : R;
        voffA[i] = (unsigned)(R * K + C) * 2u; voffB[i] = (unsigned)(Rb * K + C) * 2u; }
    const size_t kstep = (size_t)(BK * 2);
    const size_t hstep = (size_t)HALF * K * 2;
    const size_t tstep = 2 * hstep;
    const unsigned ldsw = (unsigned)wid * 1024u;
    const int aoff = lds_byte(wr * 64 + fr, fq * 8), boff = lds_byte(wc * 32 + fr, fq * 8);
#define PG8_SA(b, h) (((b) * 2 + (h)) * HTB)
#define PG8_SB(b, h) ((4 + (b) * 2 + (h)) * HTB)
#define PG8_STAGE(bufoff, gbase, voff) do { _Pragma("unroll") for (int _i = 0; _i < 2; ++_i) \
        __builtin_amdgcn_global_load_lds((const unsigned*)((const char*)(gbase) + (voff)[_i]), (PG8_LAS unsigned*)(lds + (bufoff) + ldsw + _i * 8192), 16, 0, 0); } while (0)
#define PG8_LDA(dst, b, h) do { _Pragma("unroll") for (int m = 0; m < 4; ++m) _Pragma("unroll") for (int k = 0; k < 2; ++k) dst[m][k] = *(const PG8_LAS bf16x8*)(lds + PG8_SA(b, h) + aoff + m * 2048 + k * 1024); } while (0)
#define PG8_LDB(dst, b, h) do { _Pragma("unroll") for (int n = 0; n < 2; ++n) _Pragma("unroll") for (int k = 0; k < 2; ++k) dst[n][k] = *(const PG8_LAS bf16x8*)(lds + PG8_SB(b, h) + boff + n * 2048 + k * 1024); } while (0)
#define PG8_MMA(ai, bj, At, Bt) do { __builtin_amdgcn_s_setprio(1); _Pragma("unroll") for (int m = 0; m < 4; ++m) _Pragma("unroll") for (int n = 0; n < 2; ++n) _Pragma("unroll") for (int k = 0; k < 2; ++k) \
        acc[ai][bj][m][n] = __builtin_amdgcn_mfma_f32_16x16x32_bf16(Bt[n][k], At[m][k], acc[ai][bj][m][n], 0, 0, 0); __builtin_amdgcn_s_setprio(0); } while (0)
#define PG8_WAIT_V(n) asm volatile("s_waitcnt vmcnt(" #n ")" ::: "memory")
#define PG8_WAIT_L(n) asm volatile("s_waitcnt lgkmcnt(" #n ")" ::: "memory")
#define PG8_BAR __builtin_amdgcn_s_barrier()
#define PG8_SCHED __builtin_amdgcn_sched_barrier(0)
    Unit cur, nxt; int ui = 0;
    if (!S.next(0, cur)) return;
    f32x4 acc[2][2][4][2];
#pragma unroll
    for (int a = 0; a < 2; ++a)
#pragma unroll
        for (int b = 0; b < 2; ++b)
#pragma unroll
            for (int m = 0; m < 4; ++m)
#pragma unroll
                for (int n = 0; n < 2; ++n) acc[a][b][m][n] = (f32x4){0.f, 0.f, 0.f, 0.f};
    bf16x8 At[4][2], B0[2][2], B1[2][2];
    const char* cA = (const char*)g.A + (size_t)cur.pm * tstep; const char* cB = (const char*)g.Bt + (size_t)cur.pn * tstep;
    S.a_ready(cur);
    if constexpr (SP2) {
        PG8_STAGE(PG8_SB(0, 0), cB, voffB); PG8_STAGE(PG8_SB(0, 1), cB + hstep, voffB); PG8_STAGE(PG8_SA(0, 0), cA, voffA); PG8_STAGE(PG8_SA(0, 1), cA + hstep, voffA);
        if (wr == 1) PG8_BAR;
        PG8_WAIT_V(2); PG8_BAR;
        PG8_STAGE(PG8_SB(1, 0), cB + kstep, voffB); PG8_STAGE(PG8_SA(1, 0), cA + kstep, voffA); PG8_STAGE(PG8_SB(1, 1), cB + hstep + kstep, voffB);
        PG8_WAIT_V(6); PG8_BAR;
    } else {
        PG8_STAGE(PG8_SB(0, 0), cB, voffB); PG8_STAGE(PG8_SA(0, 0), cA, voffA); PG8_STAGE(PG8_SB(0, 1), cB + hstep, voffB); PG8_STAGE(PG8_SA(0, 1), cA + hstep, voffA);
        if (wr == 1) PG8_BAR;
        PG8_WAIT_V(4); PG8_BAR;
        PG8_STAGE(PG8_SB(1, 0), cB + kstep, voffB); PG8_STAGE(PG8_SA(1, 0), cA + kstep, voffA); PG8_STAGE(PG8_SB(1, 1), cB + hstep + kstep, voffB);
        PG8_WAIT_V(6); PG8_BAR;
    }
    for (;;) {
        const bool has_next = S.next(ui + 1, nxt);
        const char* nA = has_next ? (const char*)g.A + (size_t)nxt.pm * tstep : cA; const char* nB = has_next ? (const char*)g.Bt + (size_t)nxt.pn * tstep : cB;
        for (int t = 0; t < nt; t += 2) {
            const bool last = (t == nt - 2);
            const char* a1 = cA + (size_t)(t + 1) * kstep;
            const char* a2 = last ? nA : cA + (size_t)(t + 2) * kstep; const char* b2 = last ? nB : cB + (size_t)(t + 2) * kstep;
            const char* a3 = a2 + kstep; const char* b3 = b2 + kstep;
            if (last && has_next) S.a_ready(nxt);
            if constexpr (SP2) {
            PG8_LDB(B0, 0, 0); PG8_LDB(B1, 0, 1); PG8_SCHED; PG8_LDA(At, 0, 0); PG8_STAGE(PG8_SA(1, 1), a1 + hstep, voffA);
            PG8_WAIT_V(8); PG8_WAIT_L(0); PG8_BAR; PG8_MMA(0, 0, At, B0); PG8_MMA(0, 1, At, B1); PG8_BAR; PG8_SCHED;
            PG8_LDA(At, 0, 1); PG8_STAGE(PG8_SB(0, 0), b2, voffB); PG8_STAGE(PG8_SB(0, 1), b2 + hstep, voffB); PG8_STAGE(PG8_SA(0, 0), a2, voffA);
            PG8_WAIT_V(8); PG8_WAIT_L(0); PG8_BAR; PG8_MMA(1, 0, At, B0); PG8_MMA(1, 1, At, B1); PG8_BAR; PG8_SCHED;
            PG8_LDB(B0, 1, 0); PG8_LDB(B1, 1, 1); PG8_SCHED; PG8_LDA(At, 1, 0); PG8_STAGE(PG8_SA(0, 1), a2 + hstep, voffA);
            PG8_WAIT_V(8); PG8_WAIT_L(0); PG8_BAR; PG8_MMA(0, 0, At, B0); PG8_MMA(0, 1, At, B1); PG8_BAR; PG8_SCHED;
            PG8_LDA(At, 1, 1); PG8_STAGE(PG8_SB(1, 0), b3, voffB); PG8_STAGE(PG8_SB(1, 1), b3 + hstep, voffB); PG8_STAGE(PG8_SA(1, 0), a3, voffA);
            PG8_WAIT_V(8); PG8_WAIT_L(0); PG8_BAR; PG8_MMA(1, 0, At, B0); PG8_MMA(1, 1, At, B1); PG8_BAR; PG8_SCHED;
            } else {
            PG8_LDB(B0, 0, 0); PG8_SCHED; PG8_LDA(At, 0, 0); PG8_STAGE(PG8_SA(1, 1), a1 + hstep, voffA);
            PG8_WAIT_L(8); PG8_BAR; PG8_WAIT_L(0); PG8_MMA(0, 0, At, B0); PG8_BAR; PG8_SCHED;
            PG8_LDB(B1, 0, 1); PG8_STAGE(PG8_SB(0, 0), b2, voffB);
            PG8_BAR; PG8_WAIT_L(0); PG8_MMA(0, 1, At, B1); PG8_BAR;
            PG8_LDA(At, 0, 1); PG8_STAGE(PG8_SA(0, 0), a2, voffA);
            PG8_BAR; PG8_WAIT_L(0); PG8_MMA(1, 0, At, B0); PG8_BAR; PG8_SCHED;
            PG8_STAGE(PG8_SB(0, 1), b2 + hstep, voffB);
            PG8_WAIT_V(6); PG8_BAR; PG8_MMA(1, 1, At, B1); PG8_BAR;
            PG8_LDB(B0, 1, 0); PG8_SCHED; PG8_LDA(At, 1, 0); PG8_STAGE(PG8_SA(0, 1), a2 + hstep, voffA);
            PG8_WAIT_L(8); PG8_BAR; PG8_WAIT_L(0); PG8_MMA(0, 0, At, B0); PG8_BAR; PG8_SCHED;
            PG8_LDB(B1, 1, 1); PG8_STAGE(PG8_SB(1, 0), b3, voffB);
            PG8_BAR; PG8_WAIT_L(0); PG8_MMA(0, 1, At, B1); PG8_BAR;
            PG8_LDA(At, 1, 1); PG8_STAGE(PG8_SA(1, 0), a3, voffA);
            PG8_BAR; PG8_WAIT_L(0); PG8_MMA(1, 0, At, B0); PG8_BAR; PG8_SCHED;
            PG8_STAGE(PG8_SB(1, 1), b3 + hstep, voffB);
            PG8_WAIT_V(6); PG8_BAR; PG8_MMA(1, 1, At, B1); PG8_BAR;
            }
        }
        if constexpr (ALIGN_EPI) { if (wr == 0) PG8_BAR; }
        if constexpr (!Epi::AFTER_DRAIN) { E(acc, cur, wr, wc, fr, fq); S.done(cur); }
        if (!has_next) break;
#pragma unroll
        for (int a = 0; a < 2; ++a)
#pragma unroll
            for (int b = 0; b < 2; ++b)
#pragma unroll
                for (int m = 0; m < 4; ++m)
#pragma unroll
                    for (int n = 0; n < 2; ++n) acc[a][b][m][n] = (f32x4){0.f, 0.f, 0.f, 0.f};
        cur = nxt; cA = nA; cB = nB; ++ui;
        if constexpr (ALIGN_EPI) { if (wr == 1) PG8_BAR; }
    }
    PG8_WAIT_V(0);
    if constexpr (!ALIGN_EPI) { if (wr == 0) PG8_BAR; }
    PG8_BAR;
    if constexpr (Epi::AFTER_DRAIN) { E.fused(acc, cur, wr, wc, fr, fq, lds, wid, lane); S.done(cur); }
#undef PG8_SA
#undef PG8_SB
#undef PG8_STAGE
#undef PG8_LDA
#undef PG8_LDB
#undef PG8_MMA
#undef PG8_WAIT_V
#undef PG8_WAIT_L
#undef PG8_BAR
#undef PG8_SCHED
}
}

constexpr int NWAVES = 8;
constexpr int BATCH = 4, SEQ = 4096, DM = 1024, DEPTH = 4, BR = 256;
constexpr int MTOK = BATCH * SEQ;
constexpr int IN_COLS = 3336, NPAD = 3584, PLD = 3328;
constexpr int C_AVAL = 0, C_AGATE = 256, C_AZ = 512, C_BU = 768, C_BZ = 1024, C_CB = 1280, C_CC = 1536, C_CX = 1792, C_CZ = 2048,
              C_DQ = 2304, C_DK = 2560, C_DV = 2816, C_DZ = 3072;

constexpr size_t MiB = 1u << 20;
constexpr size_t WS_CTL = 0, CTL_ZERO_BYTES = 1 * MiB;
constexpr size_t WS_WIN = 2 * MiB;
constexpr size_t WIN_BYTES = (size_t)NPAD * DM * 2;
constexpr size_t WS_WOUT = 30 * MiB;
constexpr size_t WS_SMALL = 38 * MiB;
constexpr size_t WS_S5TAB = 39 * MiB;
constexpr size_t WS_PROJ = 60 * MiB;
constexpr size_t WS_AB = 164 * MiB;
constexpr size_t WS_PART = 165 * MiB;
constexpr size_t WS_MIXED = 166 * MiB;
constexpr size_t WS_XB = 198 * MiB;
constexpr size_t WS_SCR = 198 * MiB;
constexpr size_t WS_MISC = 238 * MiB;
constexpr size_t WS_END = 256 * MiB;

constexpr int CW_BAR = 4096;
constexpr int LDS_BYTES = 147456;
constexpr int RING_BYTES = 131072, LDSCTL_OFF = RING_BYTES, MISC_OFF = LDSCTL_OFF + 320;

#define GAS __attribute__((address_space(1)))
#define LAS __attribute__((address_space(3)))
typedef unsigned short bf16;
typedef unsigned v4u __attribute__((ext_vector_type(4)));
typedef unsigned v2u __attribute__((ext_vector_type(2)));
typedef float f32x4 __attribute__((ext_vector_type(4)));
typedef short bf16x8 __attribute__((ext_vector_type(8)));
#define LDS_WAIT() asm volatile("s_waitcnt lgkmcnt(0)" ::: "memory")
#define VM_WAIT() asm volatile("s_waitcnt vmcnt(0)" ::: "memory")
typedef __bf16 bf16x2h __attribute__((ext_vector_type(2)));
typedef float f32x2h __attribute__((ext_vector_type(2)));
__device__ __forceinline__ unsigned pk2(float lo, float hi) { return __builtin_bit_cast(unsigned, __builtin_convertvector((f32x2h){lo, hi}, bf16x2h)); }
__device__ __forceinline__ unsigned f2bf(float f) { return pk2(f, 0.f) & 0xffffu; }
__device__ __forceinline__ float bf2f(unsigned short u) { return __builtin_bit_cast(float, (unsigned)u << 16); }
__device__ __forceinline__ float bflo(unsigned u) { return __builtin_bit_cast(float, u << 16); }
__device__ __forceinline__ float bfhi(unsigned u) { return __builtin_bit_cast(float, u & 0xffff0000u); }
__device__ __forceinline__ float rcpf_(float x) { return __builtin_amdgcn_rcpf(x); }
__device__ __forceinline__ float rsqf_(float x) { return __builtin_amdgcn_rsqf(x); }
__device__ __forceinline__ float sigmoidf_(float x) { return rcpf_(1.0f + __expf(-x)); }
__device__ __forceinline__ float siluf_(float x) { return x * rcpf_(1.0f + __expf(-x)); }
__device__ __forceinline__ float geluf_(float x) { const float u = 0.7978845608028654f * (x + 0.044715f * x * x * x); return x * rcpf_(1.0f + __expf(-2.0f * u)); }
__device__ __forceinline__ float softplusf_(float x) { return x > 20.f ? x : log1pf(expf(x)); }
__device__ __forceinline__ float wave_sum(float v) {
#pragma unroll
    for (int o = 1; o < 64; o <<= 1) v += __shfl_xor(v, o);
    return v;
}

#define XB_TMO      128
#define XB_XCNT(j)  (256  + 64 * (j))
#define XB_XSUB(j)  (1280 + 64 * (j))
#define XB_XGEN(j)  (2304 + 64 * (j))
#define XB_TOP      3328
#define XB_TOPGEN   3392
#define XCD_BAR_WORDS 3456
#define XB_SPIN_CAP (1u << 24)

__device__ __forceinline__ unsigned xb_ld(unsigned* p)              { return __hip_atomic_load(p, __ATOMIC_RELAXED, __HIP_MEMORY_SCOPE_AGENT); }
__device__ __forceinline__ unsigned xb_add(unsigned* p, unsigned v) { return __hip_atomic_fetch_add(p, v, __ATOMIC_RELAXED, __HIP_MEMORY_SCOPE_AGENT); }
__device__ __forceinline__ unsigned xb_xcc_id() { return (unsigned)__builtin_amdgcn_s_getreg((3 << 11) | 20) & 0xFu; }
#define XB_SPIN(cond, bar) do { unsigned _sp = 0; while (cond) { __builtin_amdgcn_s_sleep(1); \
    if ((++_sp & 255u) == 0u) { if (xb_ld(&(bar)[XB_TMO])) break; if (_sp > XB_SPIN_CAP) { atomicAdd(&(bar)[XB_TMO], 1u); break; } } } } while (0)

struct XcdBarrier {
    unsigned* bar; unsigned x;
    volatile LAS unsigned* st;
};

__device__ __forceinline__ XcdBarrier xcd_barrier_post(unsigned* bar, volatile LAS unsigned* st) {
    XcdBarrier b; b.bar = bar; b.x = xb_xcc_id(); b.st = st;
    if (threadIdx.x == 0) (void)xb_add(&bar[XB_XCNT(b.x)], 1u);
    return b;
}
__device__ __forceinline__ void xcd_barrier_complete(unsigned* bar, unsigned x, unsigned& nloc, unsigned& nx) {
    const unsigned G = gridDim.x * gridDim.y * gridDim.z;
    unsigned sum, cnt, mine, sp = 0u;
    for (;;) {
        sum = 0u; cnt = 0u; mine = 0u;
#pragma unroll
        for (unsigned j = 0; j < 16; ++j) { const unsigned c = xb_ld(&bar[XB_XCNT(j)]); sum += c; cnt += (c > 0u) ? 1u : 0u; mine = (j == x) ? c : mine; }
        if (sum == G) break;
        __builtin_amdgcn_s_sleep(1);
        if ((++sp & 255u) == 0u) { if (xb_ld(&bar[XB_TMO])) break; if (sp > XB_SPIN_CAP) { atomicAdd(&bar[XB_TMO], 1u); break; } }
    }
    nloc = mine > 0u ? mine : 1u; nx = cnt > 0u ? cnt : 1u;
}

__device__ __forceinline__ void xcd_barrier_complete_wave(unsigned* bar, unsigned x, volatile LAS unsigned* st) {
    const unsigned G = gridDim.x * gridDim.y * gridDim.z, lane = threadIdx.x & 63u;
    unsigned c = 0u, cnt = 0u, sp = 0u;
    for (;;) {
        c = (lane < 16u) ? xb_ld(&bar[XB_XCNT(lane)]) : 0u;
        unsigned sum = c; cnt = (c > 0u) ? 1u : 0u;
#pragma unroll
        for (int o = 1; o < 16; o <<= 1) { sum += (unsigned)__shfl_xor((int)sum, o); cnt += (unsigned)__shfl_xor((int)cnt, o); }
        sum = (unsigned)__builtin_amdgcn_readfirstlane((int)sum); cnt = (unsigned)__builtin_amdgcn_readfirstlane((int)cnt);
        if (sum == G) break;
        __builtin_amdgcn_s_sleep(1);
        if ((++sp & 255u) == 0u) {
            const unsigned tmo = (unsigned)__builtin_amdgcn_readfirstlane((int)xb_ld(&bar[XB_TMO]));
            if (tmo) break;
            if (sp > XB_SPIN_CAP) { if (lane == 0u) atomicAdd(&bar[XB_TMO], 1u); break; }
        }
    }
    const unsigned mine = (unsigned)__builtin_amdgcn_readlane((int)c, (int)x);
    if (lane == 0u) { st[0] = mine > 0u ? mine : 1u; st[1] = cnt > 0u ? cnt : 1u; }
}

__device__ __forceinline__ void xcd_barrier(const XcdBarrier& b) {
    asm volatile("s_waitcnt vmcnt(0)" ::: "memory");
    __syncthreads();
    if (threadIdx.x == 0) {
        unsigned* bar = b.bar;
        __builtin_amdgcn_s_waitcnt(0);
        unsigned nloc = b.st[0], nx = b.st[1];
        if (nloc == 0u) { xcd_barrier_complete(bar, b.x, nloc, nx); b.st[0] = nloc; b.st[1] = nx; }
        const unsigned old = xb_add(&bar[XB_XSUB(b.x)], 1u);
        const unsigned gen = old / nloc;
        if (old + 1u == (gen + 1u) * nloc) {
            __builtin_amdgcn_fence(__ATOMIC_RELEASE, "agent");
            asm volatile("s_waitcnt vmcnt(0)" ::: "memory");
            const unsigned og = xb_add(&bar[XB_TOP], 1u);
            const unsigned tg = og / nx;
            if (og + 1u == (tg + 1u) * nx) xb_add(&bar[XB_TOPGEN], 1u);
            else XB_SPIN(xb_ld(&bar[XB_TOPGEN]) == tg, bar);
            __builtin_amdgcn_fence(__ATOMIC_ACQUIRE, "agent");
            xb_add(&bar[XB_XGEN(b.x)], 1u);
            asm volatile("s_waitcnt vmcnt(0)" ::: "memory");
        } else {
            XB_SPIN(xb_ld(&bar[XB_XGEN(b.x)]) == gen, bar);
            __builtin_amdgcn_fence(__ATOMIC_ACQUIRE, "agent");
            asm volatile("s_waitcnt vmcnt(0)" ::: "memory");
        }
    }
    __syncthreads();
}


struct Args { const float* in[26]; float* out; unsigned char* ws; int ph_lo, ph_hi, layer, pad; };
enum { I_X = 0, I_NORMG, I_WIN, I_ACW, I_ACB, I_ALG, I_ALB, I_APW, I_APB, I_LRE, I_LIM, I_BRE, I_BIM, I_CRE, I_CIM, I_S5D, I_LOGDT, I_GLUW, I_GLUB,
       I_CCW, I_DCW, I_ALOG, I_DTB, I_DNG, I_WOUT, I_FING };

__device__ __forceinline__ const float* inptr(int i) {
    typedef const float* cfp;
    const __attribute__((address_space(4))) cfp* base = (const __attribute__((address_space(4))) cfp*)__builtin_amdgcn_kernarg_segment_ptr();
    asm volatile("" : "+s"(i));
    return (const float*)(const GAS float*)base[i];
}
__device__ __forceinline__ int win_dest(int n) { return n < 3072 ? n : (n < 3080 ? n + 256 : n - 8); }
__device__ __forceinline__ void p0_transpose_item(const float* W, int K, int N, bf16* WT, LAS float* scr, int item, int lane, const float* gs, bool perm) {
    const int nblk = (N + 31) / 32, kb = item / nblk, nb = item % nblk, k0 = 64 * kb, n0 = 32 * nb;
    typedef float f32x2t __attribute__((ext_vector_type(2)));
    f32x2t tv[16];
#pragma unroll
    for (int i = 0; i < 16; ++i) { const int kk = 4 * i + (lane >> 4); const int n = n0 + 2 * (lane & 15);
        tv[i] = (n < N) ? __builtin_nontemporal_load((const f32x2t*)&W[(size_t)(k0 + kk) * N + n]) : (f32x2t){0.f, 0.f}; }
    const float g0 = gs ? gs[k0 + (lane >> 4) + 4 * (lane & 15)] : 1.f;
#pragma unroll
    for (int i = 0; i < 16; ++i) { const int kk = 4 * i + (lane >> 4);
        const float g = __shfl(g0, i + (lane & 48));
        scr[kk * 33 + 2 * (lane & 15)] = tv[i][0] * g; scr[kk * 33 + 2 * (lane & 15) + 1] = tv[i][1] * g; }
    LDS_WAIT(); asm volatile("" ::: "memory");
    const int c = lane & 7;
#pragma unroll
    for (int j = 0; j < 4; ++j) { const int nl = (lane >> 3) + 8 * j; const int n = n0 + nl; const LAS float* s = scr + (8 * c) * 33 + nl;
        v4u o; o.x = pk2(s[0 * 33], s[1 * 33]); o.y = pk2(s[2 * 33], s[3 * 33]); o.z = pk2(s[4 * 33], s[5 * 33]); o.w = pk2(s[6 * 33], s[7 * 33]);
        if (n < N) { const int dn = perm ? win_dest(n) : n; __builtin_nontemporal_store(o, (GAS v4u*)(WT + (size_t)dn * K + k0 + 8 * c)); } }
    LDS_WAIT(); asm volatile("" ::: "memory");
}

__device__ __forceinline__ void phase_prologue(const Args& a, unsigned char* ws, LAS unsigned char* lds, int gw, int NGW, int wave, int lane) {
    LAS float* scr = (LAS float*)(lds + wave * 16384);
    constexpr int I_WIN_L = (DM / 64) * ((IN_COLS + 31) / 32);
    constexpr int I_WOUT_L = (DM / 64) * (DM / 32);
    constexpr int I_SM_L = (BR / 64) * (BR / 32);
    constexpr int PER_L = I_WIN_L + I_WOUT_L + 2 * I_SM_L;
    for (int rnd = 0; ; ++rnd) {
        const int it = gw + rnd * NGW; if (it >= DEPTH * PER_L) break;
        const int l = it / PER_L; int r = it % PER_L;
        if (r < I_WIN_L) { p0_transpose_item(inptr(I_WIN) + (size_t)l * DM * IN_COLS, DM, IN_COLS, (bf16*)(ws + WS_WIN + l * WIN_BYTES), scr, r, lane, inptr(I_NORMG) + l * DM, true); continue; } r -= I_WIN_L;
        if (r < I_WOUT_L) { p0_transpose_item(inptr(I_WOUT) + (size_t)l * DM * DM, DM, DM, (bf16*)(ws + WS_WOUT + (size_t)l * 2 * MiB), scr, r, lane, nullptr, false); continue; } r -= I_WOUT_L;
        if (r < I_SM_L) { p0_transpose_item(inptr(I_APW) + (size_t)l * BR * BR, BR, BR, (bf16*)(ws + WS_SMALL + (size_t)l * 262144), scr, r, lane, nullptr, false); continue; } r -= I_SM_L;
        p0_transpose_item(inptr(I_GLUW) + (size_t)l * BR * BR, BR, BR, (bf16*)(ws + WS_SMALL + (size_t)l * 262144 + 131072), scr, r, lane, nullptr, false);
    }
    for (int it = gw; it < DEPTH * (NPAD - IN_COLS); it += NGW) {
        const int l = it / (NPAD - IN_COLS), r = IN_COLS + it % (NPAD - IN_COLS);
        GAS v4u* p = (GAS v4u*)(ws + WS_WIN + l * WIN_BYTES + (size_t)r * DM * 2);
        p[lane] = (v4u){0u, 0u, 0u, 0u}; p[lane + 64] = (v4u){0u, 0u, 0u, 0u};
    }
    const float* x = inptr(I_X); bf16* xb = (bf16*)a.out; float* part = (float*)(ws + WS_PART);
    for (int m = gw; m < MTOK; m += NGW) {
        const GAS f32x4* xr = (const GAS f32x4*)(x + (size_t)m * DM) + lane;
        f32x4 v[4]; float s = 0.f;
#pragma unroll
        for (int j = 0; j < 4; ++j) { v[j] = __builtin_nontemporal_load(&xr[64 * j]); s += (v[j][0] * v[j][0] + v[j][1] * v[j][1]) + (v[j][2] * v[j][2] + v[j][3] * v[j][3]); }
        s = wave_sum(s);
        GAS v2u* o8 = (GAS v2u*)(xb + (size_t)m * DM) + lane;
#pragma unroll
        for (int j = 0; j < 4; ++j) { v2u w; w.x = pk2(v[j][0], v[j][1]); w.y = pk2(v[j][2], v[j][3]); o8[64 * j] = w; }
        if (lane < 16) part[(size_t)m * 16 + lane] = (lane == 0) ? s : 0.f;
    }
}

__device__ __forceinline__ void phase_final_norm(const Args& a, const bf16* xl, int gw, int NGW, int lane) {
    const float* fg = inptr(I_FING);
    f32x4 g[4];
#pragma unroll
    for (int j = 0; j < 4; ++j) g[j] = ((const GAS f32x4*)fg)[lane + 64 * j];
    for (int m = gw; m < MTOK; m += NGW) {
        const GAS v2u* xr = (const GAS v2u*)(xl + (size_t)m * DM) + lane;
        GAS f32x4* orow = (GAS f32x4*)(a.out + (size_t)m * DM) + lane;
        f32x4 v[4]; float s = 0.f;
#pragma unroll
        for (int j = 0; j < 4; ++j) { const v2u w = __builtin_nontemporal_load(&xr[64 * j]); v[j] = (f32x4){bflo(w.x), bfhi(w.x), bflo(w.y), bfhi(w.y)}; s += (v[j][0] * v[j][0] + v[j][1] * v[j][1]) + (v[j][2] * v[j][2] + v[j][3] * v[j][3]); }
        s = wave_sum(s);
        const float rstd = rsqf_(s * (1.0f / DM) + 1e-6f);
#pragma unroll
        for (int j = 0; j < 4; ++j) __builtin_nontemporal_store(v[j] * rstd * g[j], &orow[64 * j]);
    }
}


constexpr size_t MISC_SP = 0, MISC_BT = 8 * MiB, MISC_XLOC = 16 * MiB, CTL_EGL = 512 * 1024;
constexpr int DNL_WAVE_LDS = 65024;
#define MFMA16(a, b, c) __builtin_amdgcn_mfma_f32_16x16x32_bf16(a, b, c, 0, 0, 0)
__device__ __forceinline__ v2u pack4(const f32x4 v) { v2u w; w.x = pk2(v[0], v[1]); w.y = pk2(v[2], v[3]); return w; }
__device__ __forceinline__ bf16x8 pack8(const f32x4 a, const f32x4 b) { v4u w; w.x = pk2(a[0], a[1]); w.y = pk2(a[2], a[3]); w.z = pk2(b[0], b[1]); w.w = pk2(b[2], b[3]); return __builtin_bit_cast(bf16x8, w); }
__device__ __forceinline__ void unpack8(const v4u r, float (&x)[8]) { x[0] = bflo(r.x); x[1] = bfhi(r.x); x[2] = bflo(r.y); x[3] = bfhi(r.y); x[4] = bflo(r.z); x[5] = bfhi(r.z); x[6] = bflo(r.w); x[7] = bfhi(r.w); }

constexpr size_t S5G_BYTES = 335872;
constexpr int S5_POW = 0, S5_KT = 36864, S5_CC = 69632, S5_BM = 73728;
typedef float f32x2v __attribute__((ext_vector_type(2)));

__device__ __forceinline__ f32x2v cmul_(f32x2v a, f32x2v b) { return (f32x2v){a.x * b.x - a.y * b.y, a.x * b.y + a.y * b.x}; }
__device__ __forceinline__ void s5_tables(unsigned char* ws, LAS unsigned char* lds, int item, int tid) {
    const int lg = item >> 2, q = item & 3;
    unsigned char* tb = ws + WS_S5TAB + (size_t)lg * S5G_BYTES;
    f32x2v* gPOW = (f32x2v*)(tb + S5_POW); bf16* gKT = (bf16*)(tb + S5_KT); bf16* gCC = (bf16*)(tb + S5_CC); bf16* gBM = (bf16*)(tb + S5_BM);
    LAS f32x2v* POWs = (LAS f32x2v*)lds; LAS f32x2v* BBs = (LAS f32x2v*)(lds + 33280); LAS f32x2v* Cs = (LAS f32x2v*)(lds + 41472);
    const float* lre = inptr(I_LRE) + lg * 64; const float* lim = inptr(I_LIM) + lg * 64;
    __syncthreads();
    const float dt = expf(inptr(I_LOGDT)[lg]);
    float lr_[2], li_[2], br_[2], bi_[2], cr_[2], ci_[2];
#pragma unroll
    for (int k = 0; k < 2; ++k) { const int e = tid + 512 * k, p = e >> 4, h = e & 15;
        lr_[k] = fminf(lre[p], -1e-4f); li_[k] = lim[p]; br_[k] = inptr(I_BRE)[(lg * 64 + p) * 16 + h]; bi_[k] = inptr(I_BIM)[(lg * 64 + p) * 16 + h];
        cr_[k] = inptr(I_CRE)[lg * 1024 + e]; ci_[k] = inptr(I_CIM)[lg * 1024 + e]; }
    {
        const int p = tid & 63, j = tid >> 6; const float lr = fminf(lre[p], -1e-4f) * dt, li = lim[p] * dt;
        const float mag = expf(lr); float sn, cs; sincosf(li, &sn, &cs);
        const f32x2v l1 = (f32x2v){mag * cs, mag * sn}, l2 = cmul_(l1, l1), l4 = cmul_(l2, l2), l8 = cmul_(l4, l4);
        f32x2v cur = (f32x2v){1.f, 0.f};
        if (j & 1) cur = cmul_(cur, l1);
        if (j & 2) cur = cmul_(cur, l2);
        if (j & 4) cur = cmul_(cur, l4);
#pragma unroll
        for (int i = 0; i < 9; ++i) {
            const int t = j + 8 * i;
            if (t <= 64) { POWs[t * 64 + p] = cur; if (q == 0) gPOW[t * 64 + p] = cur; }
            cur = cmul_(cur, l8);
        }
    }
#pragma unroll
    for (int k = 0; k < 2; ++k) { const int e = tid + 512 * k; const float lr = lr_[k], li = li_[k];
        const float mag = expf(lr * dt); float sn, cs; sincosf(li * dt, &sn, &cs);
        const float ar = mag * cs - 1.f, ai = mag * sn, den = lr * lr + li * li;
        const float cfr = (ar * lr + ai * li) / den, cfi = (ai * lr - ar * li) / den;
        BBs[e] = (f32x2v){cfr * br_[k] - cfi * bi_[k], cfr * bi_[k] + cfi * br_[k]};
        Cs[e] = (f32x2v){cr_[k], ci_[k]}; }
    __syncthreads();
    {
        const int pair = tid & 255, h = pair >> 4, hp = pair & 15, half = tid >> 8;
        float acc[8];
#pragma unroll
        for (int j = 0; j < 8; ++j) acc[j] = 0.f;
#pragma unroll 2
        for (int p = 0; p < 64; ++p) {
            const f32x2v c = Cs[h * 64 + p], bb = BBs[p * 16 + hp];
            const float cmr = c.x * bb.x - c.y * bb.y, cmi = c.x * bb.y + c.y * bb.x;
#pragma unroll
            for (int j = 0; j < 8; ++j) { const f32x2v pw = POWs[(16 * q + 8 * half + j) * 64 + p]; acc[j] += cmr * pw.x - cmi * pw.y; }
        }
#pragma unroll
        for (int j = 0; j < 8; ++j) gKT[(h * 64 + 16 * q + 8 * half + j) * 16 + hp] = (bf16)f2bf(acc[j]);
    }
#pragma unroll 2
    for (int k = 0; k < 4; ++k) {
        const int u = tid + 512 * k, cl = u & 31, p = u >> 5, chunk = 32 * q + cl, sx = chunk >> 1, h0 = (chunk & 1) * 8;
        const f32x2v pw = POWs[(63 - sx) * 64 + p];
        float vr[8], vi[8];
#pragma unroll
        for (int e = 0; e < 8; ++e) { const f32x2v bb = BBs[p * 16 + h0 + e]; vr[e] = pw.x * bb.x - pw.y * bb.y; vi[e] = pw.x * bb.y + pw.y * bb.x; }
        v4u w; w.x = pk2(vr[0], vr[1]); w.y = pk2(vr[2], vr[3]); w.z = pk2(vr[4], vr[5]); w.w = pk2(vr[6], vr[7]);
        __builtin_nontemporal_store(w, (v4u*)(gBM + (size_t)(2 * p) * 1024 + chunk * 8));
        w.x = pk2(vi[0], vi[1]); w.y = pk2(vi[2], vi[3]); w.z = pk2(vi[4], vi[5]); w.w = pk2(vi[6], vi[7]);
        __builtin_nontemporal_store(w, (v4u*)(gBM + (size_t)(2 * p + 1) * 1024 + chunk * 8));
    }
    if (q == 0) {
        for (int k = 0; k < 4; ++k) {
            const int e = tid + 512 * k, h = e >> 7, k2 = e & 127, p = k2 >> 1, ri = k2 & 1;
            const f32x2v c = Cs[h * 64 + p];
            gCC[e] = (bf16)f2bf(ri ? -c.y : c.x);
        }
    }
}

__device__ __forceinline__ void s5_xloc2(int l, unsigned char* ws, int item, int k, int lane) {
    asm volatile("" : "+v"(lane));
    const int g = item >> 4, cs = item & 15, gq = lane >> 4, ln = lane & 15;
    const bf16* proj = (const bf16*)(ws + WS_PROJ);
    const bf16* gBM = (const bf16*)(ws + WS_S5TAB + (size_t)(l * 16 + g) * S5G_BYTES + S5_BM);
    const bf16* ap = gBM + (size_t)(32 * k + ln) * 1024 + 8 * gq;
    const bf16* bp = proj + (size_t)((cs * 16 + ln) * 64 + (gq >> 1)) * PLD + C_BU + g * 16 + 8 * (gq & 1);
    f32x4 acc0[2], acc1[2];
#pragma unroll
    for (int j = 0; j < 2; ++j) { acc0[j] = (f32x4){0.f, 0.f, 0.f, 0.f}; acc1[j] = (f32x4){0.f, 0.f, 0.f, 0.f}; }
    bf16x8 A0[3][4], A1[3][4], Bf[3][4];
#define XL_LOAD(buf, bt) do { _Pragma("unroll") for (int j_ = 0; j_ < 4; ++j_) { const int ks_ = 4 * (bt) + j_; \
        A0[buf][j_] = *(const bf16x8*)(ap + 32 * ks_); A1[buf][j_] = *(const bf16x8*)(ap + 16 * 1024 + 32 * ks_); Bf[buf][j_] = *(const bf16x8*)(bp + (size_t)(2 * ks_) * PLD); } } while (0)
    XL_LOAD(0, 0); XL_LOAD(1, 1);
#pragma unroll
    for (int bt = 0; bt < 8; ++bt) {
        __builtin_amdgcn_sched_barrier(0);
#pragma unroll
        for (int j = 0; j < 4; ++j) { acc0[j & 1] = MFMA16(A0[bt % 3][j], Bf[bt % 3][j], acc0[j & 1]); acc1[j & 1] = MFMA16(A1[bt % 3][j], Bf[bt % 3][j], acc1[j & 1]); }
        __builtin_amdgcn_sched_barrier(0);
        if (bt + 2 < 8) XL_LOAD((bt + 2) % 3, bt + 2);
        asm volatile("" :: "v"(A0[bt % 3][0]), "v"(A0[bt % 3][1]), "v"(A0[bt % 3][2]), "v"(A0[bt % 3][3]), "v"(A1[bt % 3][0]), "v"(A1[bt % 3][1]), "v"(A1[bt % 3][2]), "v"(A1[bt % 3][3]),
                              "v"(Bf[bt % 3][0]), "v"(Bf[bt % 3][1]), "v"(Bf[bt % 3][2]), "v"(Bf[bt % 3][3]));
    }
#undef XL_LOAD
    float* xl = (float*)(ws + WS_MISC + MISC_XLOC) + ((size_t)(cs * 16 + ln) * 16 + g) * 128 + 32 * k + 4 * gq;
    *(f32x4*)xl = acc0[0] + acc0[1]; *(f32x4*)(xl + 16) = acc1[0] + acc1[1];
}

__device__ __forceinline__ void s5_scan(int l, unsigned char* ws, int e) {
    const int b = e >> 10, g = (e >> 6) & 15, p = e & 63;
    const f32x2v lc = ((const f32x2v*)(ws + WS_S5TAB + (size_t)(l * 16 + g) * S5G_BYTES + S5_POW))[64 * 64 + p];
    f32x2v* xp = (f32x2v*)((float*)(ws + WS_MISC + MISC_XLOC) + ((size_t)(b * 64) * 16 + g) * 128) + p;
    float xr = 0.f, xi = 0.f;
#pragma unroll 1
    for (int n0 = 0; n0 < 64; n0 += 32) {
        f32x2v v[32];
#pragma unroll
        for (int j = 0; j < 32; ++j) v[j] = xp[(size_t)(n0 + j) * 1024];
#pragma unroll
        for (int j = 0; j < 32; ++j) {
            xp[(size_t)(n0 + j) * 1024] = (f32x2v){xr, xi};
            const float nr = lc.x * xr - lc.y * xi + v[j].x, ni = lc.x * xi + lc.y * xr + v[j].y; xr = nr; xi = ni;
        }
    }
}

constexpr int S5O_YL = 65536, S5O_YLD = 528;
#define S5_LOADB(dst, kp, qb) do { _Pragma("unroll") for (int q_ = 0; q_ < 16; ++q_) dst[q_] = *(const bf16x8*)((kp) + 32 * ((qb) + q_)); } while (0)
#define S5_TOEP(src, ub, qb) do { _Pragma("unroll") for (int q_ = 0; q_ < 8; ++q_) { _Pragma("unroll") for (int mt = 0; mt < 4; ++mt) { if (8 * mt + 7 >= (qb) + q_) { \
        const bf16x8 afr_ = *(const LAS bf16x8*)((ub) + (16 * mt - 2 * ((qb) + q_)) * 32); acc[mt] = MFMA16(afr_, src[q_], acc[mt]); \
        if (mt < 3) acc[mt < 3 ? mt + 1 : 3] = MFMA16(afr_, src[q_ + 8], acc[mt < 3 ? mt + 1 : 3]); } } } } while (0)
__device__ __forceinline__ void s5_state_epi(int l, unsigned char* ws, const unsigned char* tb, const f32x4 (&xv)[4][2], const LAS unsigned char* UL, LAS unsigned char* YL, int g, f32x4 (&acc)[4], int gq, int ln) {
    const bf16* gCC = (const bf16*)(tb + S5_CC); const float* gPOW = (const float*)(tb + S5_POW);
    {
        bf16x8 cfr[4]; f32x4 z0[4], z1[4], l0[4], l1[4], pq0[4], pq1[4];
#pragma unroll
        for (int ks = 0; ks < 4; ++ks) {
            cfr[ks] = *(const bf16x8*)(gCC + ln * 128 + 32 * ks + 8 * gq);
            const float* pp = gPOW + ((ln + 1) * 64 + 16 * ks + 4 * gq) * 2;
            pq0[ks] = *(const f32x4*)pp; pq1[ks] = *(const f32x4*)(pp + 4);
            const float* lp = gPOW + (16 * 64 + 16 * ks + 4 * gq) * 2;
            l0[ks] = *(const f32x4*)lp; l1[ks] = *(const f32x4*)(lp + 4);
        }
        asm volatile("" ::: "memory"); __builtin_amdgcn_sched_barrier(0);
#pragma unroll
        for (int ks = 0; ks < 4; ++ks) {
            const f32x4 x0 = xv[ks][0], x1 = xv[ks][1];
            const f32x4 p0 = pq0[ks], p1 = pq1[ks];
            z0[ks] = (f32x4){p0[0] * x0[0] - p0[1] * x0[1], p0[0] * x0[1] + p0[1] * x0[0], p0[2] * x0[2] - p0[3] * x0[3], p0[2] * x0[3] + p0[3] * x0[2]};
            z1[ks] = (f32x4){p1[0] * x1[0] - p1[1] * x1[1], p1[0] * x1[1] + p1[1] * x1[0], p1[2] * x1[2] - p1[3] * x1[3], p1[2] * x1[3] + p1[3] * x1[2]};
        }
#pragma unroll
        for (int mt = 0; mt < 4; ++mt) {
#pragma unroll
            for (int ks = 0; ks < 4; ++ks) {
                acc[mt] = MFMA16(pack8(z0[ks], z1[ks]), cfr[ks], acc[mt]);
                if (mt < 3) {
                    const f32x4 a = z0[ks], b2 = z1[ks], la = l0[ks], lb = l1[ks];
                    z0[ks] = (f32x4){la[0] * a[0] - la[1] * a[1], la[0] * a[1] + la[1] * a[0], la[2] * a[2] - la[3] * a[3], la[2] * a[3] + la[3] * a[2]};
                    z1[ks] = (f32x4){lb[0] * b2[0] - lb[1] * b2[1], lb[0] * b2[1] + lb[1] * b2[0], lb[2] * b2[2] - lb[3] * b2[3], lb[2] * b2[3] + lb[3] * b2[2]};
                }
            }
        }
    }
    const float dsk = inptr(I_S5D)[l * 256 + g * 16 + ln];
#pragma unroll
    for (int mt = 0; mt < 4; ++mt)
#pragma unroll
        for (int r = 0; r < 4; ++r) {
            const int t = 16 * mt + 4 * gq + r;
            const float u = bf2f(*(const LAS unsigned short*)(UL + (64 + t) * 32 + ln * 2));
            *(LAS unsigned short*)(YL + t * S5O_YLD + (g * 16 + ln) * 2) = (unsigned short)f2bf(geluf_(acc[mt][r] + dsk * u));
        }
}
__device__ __forceinline__ void s5_groups(int l, unsigned char* ws, LAS unsigned char* lds, int ci, int wave, int lane) {
    asm volatile("" : "+v"(lane));
    const int gq = lane >> 4, ln = lane & 15;
    const bf16* proj = (const bf16*)(ws + WS_PROJ); bf16* mixed = (bf16*)(ws + WS_MIXED);
    const size_t tok0 = (size_t)ci * 64;
    LAS unsigned char* UL0 = lds + wave * 8192; LAS unsigned char* UL1 = UL0 + 4096; LAS unsigned char* YL = lds + S5O_YL;
    const int g0 = 2 * wave, g1 = g0 + 1;
    const unsigned char* tb0 = ws + WS_S5TAB + (size_t)(l * 16 + g0) * S5G_BYTES; const unsigned char* tb1 = tb0 + S5G_BYTES;
    const bf16* kp0 = (const bf16*)(tb0 + S5_KT) + (ln * 64 + (gq >> 1)) * 16 + 8 * (gq & 1);
    const bf16* kp1 = (const bf16*)(tb1 + S5_KT) + (ln * 64 + (gq >> 1)) * 16 + 8 * (gq & 1);
    const float* xin0 = (const float*)(ws + WS_MISC + MISC_XLOC) + ((size_t)ci * 16 + g0) * 128;
    bf16x8 bA[16], bB[16];
    S5_LOADB(bA, kp0, 0);
    f32x4 xv0[4][2], xv1[4][2];
#pragma unroll
    for (int ks = 0; ks < 4; ++ks) { xv0[ks][0] = *(const f32x4*)(xin0 + 2 * (16 * ks + 4 * gq)); xv0[ks][1] = *(const f32x4*)(xin0 + 2 * (16 * ks + 4 * gq) + 4); }
    const bf16* up = proj + (tok0 + lane) * PLD + C_BU + g0 * 16;
    const v4u u00 = *(const v4u*)up, u01 = *(const v4u*)(up + 8), u10 = *(const v4u*)(up + 16), u11 = *(const v4u*)(up + 24);
    const v4u z4 = (v4u){0u, 0u, 0u, 0u};
    *(LAS v4u*)(UL0 + lane * 32) = z4; *(LAS v4u*)(UL0 + lane * 32 + 16) = z4; *(LAS v4u*)(UL1 + lane * 32) = z4; *(LAS v4u*)(UL1 + lane * 32 + 16) = z4;
    *(LAS v4u*)(UL0 + (64 + lane) * 32) = u00; *(LAS v4u*)(UL0 + (64 + lane) * 32 + 16) = u01;
    *(LAS v4u*)(UL1 + (64 + lane) * 32) = u10; *(LAS v4u*)(UL1 + (64 + lane) * 32 + 16) = u11;
    S5_LOADB(bB, kp0, 16);
    asm volatile("" ::: "memory"); __builtin_amdgcn_sched_barrier(0);
    LDS_WAIT();
    const LAS unsigned char* ub0 = UL0 + (64 + ln - (gq >> 1)) * 32 + 16 * (gq & 1);
    const LAS unsigned char* ub1 = UL1 + (64 + ln - (gq >> 1)) * 32 + 16 * (gq & 1);
    {
        f32x4 acc[4];
#pragma unroll
        for (int mt = 0; mt < 4; ++mt) acc[mt] = (f32x4){0.f, 0.f, 0.f, 0.f};
        S5_TOEP(bA, ub0, 0);
        asm volatile("" ::: "memory"); __builtin_amdgcn_sched_barrier(0);
        S5_LOADB(bA, kp1, 0);
        asm volatile("" ::: "memory"); __builtin_amdgcn_sched_barrier(0);
        S5_TOEP(bB, ub0, 16);
        __builtin_amdgcn_sched_barrier(0);
        s5_state_epi(l, ws, tb0, xv0, UL0, YL, g0, acc, gq, ln);
        __builtin_amdgcn_sched_barrier(0);
    }
    {
        f32x4 acc[4];
#pragma unroll
        for (int mt = 0; mt < 4; ++mt) acc[mt] = (f32x4){0.f, 0.f, 0.f, 0.f};
        S5_LOADB(bB, kp1, 16);
#pragma unroll
        for (int ks = 0; ks < 4; ++ks) { xv1[ks][0] = *(const f32x4*)(xin0 + 128 + 2 * (16 * ks + 4 * gq)); xv1[ks][1] = *(const f32x4*)(xin0 + 128 + 2 * (16 * ks + 4 * gq) + 4); }
        asm volatile("" ::: "memory"); __builtin_amdgcn_sched_barrier(0);
        S5_TOEP(bA, ub1, 0);
        S5_TOEP(bB, ub1, 16);
        __builtin_amdgcn_sched_barrier(0);
        s5_state_epi(l, ws, tb1, xv1, UL1, YL, g1, acc, gq, ln);
        __builtin_amdgcn_sched_barrier(0);
    }
}
__device__ __forceinline__ void s5_glu(int l, unsigned char* ws, LAS unsigned char* lds, int ci, int wave, int lane) {
    asm volatile("" : "+v"(lane));
    const int gq = lane >> 4, ln = lane & 15;
    const bf16* proj = (const bf16*)(ws + WS_PROJ); bf16* mixed = (bf16*)(ws + WS_MIXED);
    const size_t tok0 = (size_t)ci * 64;
    LAS unsigned char* YL = lds + S5O_YL;
    const bf16* gw = (const bf16*)(ws + WS_SMALL + (size_t)l * 262144 + 131072);
    const float* gb = inptr(I_GLUB) + l * 256;
    bf16x8 afr[8], afr1[8]; v2u zv[2][4]; f32x4 gbias[2];
    gbias[0] = *(const f32x4*)(gb + 32 * wave + 4 * gq); gbias[1] = *(const f32x4*)(gb + 32 * wave + 16 + 4 * gq);
#pragma unroll
    for (int ks = 0; ks < 8; ++ks) afr[ks] = *(const bf16x8*)(gw + (size_t)(32 * wave + ln) * 256 + 32 * ks + 8 * gq);
#pragma unroll
    for (int nt2 = 0; nt2 < 2; ++nt2)
#pragma unroll
        for (int tt = 0; tt < 4; ++tt) zv[nt2][tt] = *(const v2u*)(proj + (tok0 + 16 * tt + ln) * PLD + C_BZ + 32 * wave + 16 * nt2 + 4 * gq);
    LDS_WAIT(); __syncthreads();
#pragma unroll
    for (int nt2 = 0; nt2 < 2; ++nt2) {
        const int n0 = 32 * wave + 16 * nt2;
        f32x4 acc[4];
#pragma unroll
        for (int tt = 0; tt < 4; ++tt) acc[tt] = (f32x4){0.f, 0.f, 0.f, 0.f};
        if (nt2 == 0) {
#pragma unroll
            for (int ks = 0; ks < 8; ++ks) afr1[ks] = *(const bf16x8*)(gw + (size_t)(32 * wave + 16 + ln) * 256 + 32 * ks + 8 * gq);
        }
#pragma unroll
        for (int ks = 0; ks < 8; ++ks) {
#pragma unroll
            for (int tt = 0; tt < 4; ++tt) {
                const bf16x8 bfr = *(const LAS bf16x8*)(YL + (16 * tt + ln) * S5O_YLD + (32 * ks + 8 * gq) * 2);
                acc[tt] = MFMA16(nt2 ? afr1[ks] : afr[ks], bfr, acc[tt]);
            }
        }
        const f32x4 bias = gbias[nt2];
#pragma unroll
        for (int tt = 0; tt < 4; ++tt) {
            const int t = 16 * tt + ln; const int nn = n0 + 4 * gq;
            const v2u yv = *(const LAS v2u*)(YL + t * S5O_YLD + nn * 2);
            const v2u z = zv[nt2][tt];
            f32x4 o;
            o[0] = bflo(yv.x) * sigmoidf_(acc[tt][0] + bias[0]) * siluf_(bflo(z.x));
            o[1] = bfhi(yv.x) * sigmoidf_(acc[tt][1] + bias[1]) * siluf_(bfhi(z.x));
            o[2] = bflo(yv.y) * sigmoidf_(acc[tt][2] + bias[2]) * siluf_(bflo(z.y));
            o[3] = bfhi(yv.y) * sigmoidf_(acc[tt][3] + bias[3]) * siluf_(bfhi(z.y));
            *(v2u*)(mixed + (tok0 + t) * DM + 256 + nn) = pack4(o);
        }
    }
}
constexpr int AB_CV = 49152, AB_ACTLD = 528;
__device__ __forceinline__ float dpp_add_(float v, const int ctrl_is_qp1, const int which) {
    const int x = __builtin_bit_cast(int, v); int t;
    if (which == 0) t = __builtin_amdgcn_update_dpp(0, x, 0xB1, 0xf, 0xf, true);
    else if (which == 1) t = __builtin_amdgcn_update_dpp(0, x, 0x4E, 0xf, 0xf, true);
    else if (which == 2) t = __builtin_amdgcn_update_dpp(0, x, 0x141, 0xf, 0xf, true);
    else t = __builtin_amdgcn_update_dpp(0, x, 0x140, 0xf, 0xf, true);
    return v + __builtin_bit_cast(float, t);
}
#define LN_REDUCE8(sm) do { _Pragma("unroll") for (int st_ = 0; st_ < 4; ++st_) { _Pragma("unroll") for (int j_ = 0; j_ < 8; ++j_) sm[j_] = dpp_add_(sm[j_], 0, st_); } \
    _Pragma("unroll") for (int j_ = 0; j_ < 8; ++j_) sm[j_] += __shfl_xor(sm[j_], 16); _Pragma("unroll") for (int j_ = 0; j_ < 8; ++j_) sm[j_] += __shfl_xor(sm[j_], 32); } while (0)
__device__ __forceinline__ void a_branch(int l, unsigned char* ws, LAS unsigned char* lds, int ci, int tid) {
    asm volatile("" : "+v"(tid));
    const int lane = tid & 63, wave = tid >> 6, gq = lane >> 4, ln = lane & 15;
    const bf16* proj = (const bf16*)(ws + WS_PROJ); bf16* mixed = (bf16*)(ws + WS_MIXED);
    const size_t tok0 = (size_t)ci * 64; const int n = ci & 63;
    LAS unsigned char* AT = lds; LAS float* CV = (LAS float*)(lds + AB_CV); LAS unsigned char* ACT = lds;
    __syncthreads();
    {
        const int c8 = tid & 31, r0 = tid >> 5;
        v4u rv[6], rg[6];
#pragma unroll
        for (int ps = 0; ps < 6; ++ps) {
            const int rr = r0 + 16 * ps;
            rv[ps] = (v4u){0u, 0u, 0u, 0u}; rg[ps] = (v4u){0u, 0u, 0u, 0u};
            if (rr < 94 && (n > 0 || rr >= 30)) { const bf16* p = proj + (tok0 + rr - 30) * PLD + c8 * 8; rv[ps] = *(const v4u*)(p + C_AVAL); rg[ps] = *(const v4u*)(p + C_AGATE); }
        }
#pragma unroll
        for (int ps = 0; ps < 6; ++ps) {
            const int rr = r0 + 16 * ps;
            if (rr < 94) {
                float v[8], gt[8]; unpack8(rv[ps], v); unpack8(rg[ps], gt);
#pragma unroll
                for (int e = 0; e < 8; ++e) v[e] *= sigmoidf_(gt[e]);
                v4u w; w.x = pk2(v[0], v[1]); w.y = pk2(v[2], v[3]); w.z = pk2(v[4], v[5]); w.w = pk2(v[6], v[7]);
                *(LAS v4u*)(AT + rr * 512 + c8 * 16) = w;
            }
        }
    }
    __syncthreads();
    {
        const int c = tid & 255, th = tid >> 8;
        const float* cw = inptr(I_ACW) + l * 31 * 256 + c;
        typedef float f32x2p __attribute__((ext_vector_type(2)));
        float u[33];
        u[0] = 0.f; u[32] = 0.f;
#pragma unroll
        for (int k = 0; k < 31; ++k) u[31 - k] = cw[k * 256];
        const float bias = inptr(I_ACB)[l * 256 + c];
        f32x2p o2[16];
#pragma unroll
        for (int i = 0; i < 16; ++i) o2[i] = (f32x2p){bias, bias};
#pragma unroll
        for (int rr = 0; rr < 62; ++rr) {
            const float a = bf2f(*(const LAS unsigned short*)(AT + (32 * th + rr) * 512 + c * 2));
            const f32x2p a2 = (f32x2p){a, a};
#pragma unroll
            for (int i2 = 0; i2 < 16; ++i2) {
                const int j = 30 - rr + 2 * i2;
                if (j >= -1 && j <= 30) o2[i2] = __builtin_elementwise_fma((f32x2p){u[1 + j], u[2 + j]}, a2, o2[i2]);
            }
        }
        float out[32];
#pragma unroll
        for (int i = 0; i < 16; ++i) { out[2 * i] = o2[i][0]; out[2 * i + 1] = o2[i][1]; }
#pragma unroll
        for (int i = 0; i < 32; ++i) CV[(32 * th + i) * 256 + c] = out[i];
    }
    __syncthreads();
    const float* gb = inptr(I_APB) + l * 256;
    v2u zv[2][4]; f32x4 pbias[2];
#pragma unroll
    for (int nt2 = 0; nt2 < 2; ++nt2) {
        pbias[nt2] = *(const f32x4*)(gb + 32 * wave + 16 * nt2 + 4 * gq);
#pragma unroll
        for (int tt = 0; tt < 4; ++tt) zv[nt2][tt] = *(const v2u*)(proj + (tok0 + 16 * tt + ln) * PLD + C_AZ + 32 * wave + 16 * nt2 + 4 * gq);
    }
    asm volatile("" ::: "memory");
    {
        const f32x4 lg = *(const f32x4*)(inptr(I_ALG) + l * 256 + lane * 4), lb = *(const f32x4*)(inptr(I_ALB) + l * 256 + lane * 4);
        f32x4 v[8]; float sm[8];
#pragma unroll
        for (int j = 0; j < 8; ++j) { v[j] = *(const LAS f32x4*)(CV + (wave * 8 + j) * 256 + lane * 4); sm[j] = (v[j][0] + v[j][1]) + (v[j][2] + v[j][3]); }
        LN_REDUCE8(sm);
#pragma unroll
        for (int j = 0; j < 8; ++j) { v[j] = v[j] - sm[j] * (1.f / 256.f); sm[j] = (v[j][0] * v[j][0] + v[j][1] * v[j][1]) + (v[j][2] * v[j][2] + v[j][3] * v[j][3]); }
        LN_REDUCE8(sm);
#pragma unroll
        for (int j = 0; j < 8; ++j) {
            const float rs = rsqf_(sm[j] * (1.f / 256.f) + 1e-6f);
            f32x4 y = v[j] * rs * lg + lb;
            y[0] = siluf_(y[0]); y[1] = siluf_(y[1]); y[2] = siluf_(y[2]); y[3] = siluf_(y[3]);
            *(LAS v2u*)(ACT + (wave * 8 + j) * AB_ACTLD + lane * 8) = pack4(y);
        }
    }
    __syncthreads();
    const bf16* gw = (const bf16*)(ws + WS_SMALL + (size_t)l * 262144);
    bf16x8 afr[2][8];
#pragma unroll
    for (int nt2 = 0; nt2 < 2; ++nt2)
#pragma unroll
        for (int ks = 0; ks < 8; ++ks) afr[nt2][ks] = *(const bf16x8*)(gw + (size_t)(32 * wave + 16 * nt2 + ln) * 256 + 32 * ks + 8 * gq);
#pragma unroll
    for (int nt2 = 0; nt2 < 2; ++nt2) {
        const int n0 = 32 * wave + 16 * nt2;
        f32x4 acc[4];
#pragma unroll
        for (int tt = 0; tt < 4; ++tt) acc[tt] = (f32x4){0.f, 0.f, 0.f, 0.f};
#pragma unroll
        for (int ks = 0; ks < 8; ++ks) {
#pragma unroll
            for (int tt = 0; tt < 4; ++tt) {
                const bf16x8 bfr = *(const LAS bf16x8*)(ACT + (16 * tt + ln) * AB_ACTLD + (32 * ks + 8 * gq) * 2);
                acc[tt] = MFMA16(afr[nt2][ks], bfr, acc[tt]);
            }
        }
        const f32x4 bias = pbias[nt2];
#pragma unroll
        for (int tt = 0; tt < 4; ++tt) {
            const int t = 16 * tt + ln; const int nn = n0 + 4 * gq;
            const v2u z = zv[nt2][tt];
            f32x4 o;
            o[0] = (acc[tt][0] + bias[0]) * siluf_(bflo(z.x)); o[1] = (acc[tt][1] + bias[1]) * siluf_(bfhi(z.x));
            o[2] = (acc[tt][2] + bias[2]) * siluf_(bflo(z.y)); o[3] = (acc[tt][3] + bias[3]) * siluf_(bfhi(z.y));
            *(v2u*)(mixed + (tok0 + t) * DM + nn) = pack4(o);
        }
    }
}

__device__ __forceinline__ void c_branch4(int l, unsigned char* ws, int bx, int tid, int nthr) {
    const bf16* proj = (const bf16*)(ws + WS_PROJ); bf16* mixed = (bf16*)(ws + WS_MIXED);
    const float* cw = inptr(I_CCW) + l * 768;
#pragma unroll 1
    for (int u = tid; u < 1024; u += nthr) {
        const int ci = bx + 64 * (u >> 8), tb = (u >> 5) & 7, c8 = u & 31;
        const size_t tokb = (size_t)ci * 64 + tb * 8;
        const bool first = ((ci & 63) == 0) && tb == 0;
        const bf16* p = proj + tokb * PLD + c8 * 8;
        v4u ra[10], rb[10], rc[8], rz[8];
#pragma unroll
        for (int r = 0; r < 10; ++r) {
            ra[r] = (v4u){0u, 0u, 0u, 0u}; rb[r] = (v4u){0u, 0u, 0u, 0u};
            if (r >= 2 || !first) { ra[r] = *(const v4u*)(p + (r - 2) * PLD + C_CC); rb[r] = *(const v4u*)(p + (r - 2) * PLD + C_CX); }
        }
#pragma unroll
        for (int r = 0; r < 8; ++r) { rc[r] = *(const v4u*)(p + r * PLD + C_CB); rz[r] = *(const v4u*)(p + r * PLD + C_CZ); }
        float w0[8], w1[8], w2[8];
        { const f32x4 a0 = *(const f32x4*)(cw + c8 * 8), a1 = *(const f32x4*)(cw + c8 * 8 + 4), b0 = *(const f32x4*)(cw + 256 + c8 * 8), b1 = *(const f32x4*)(cw + 256 + c8 * 8 + 4),
                      c0 = *(const f32x4*)(cw + 512 + c8 * 8), c1 = *(const f32x4*)(cw + 512 + c8 * 8 + 4);
#pragma unroll
          for (int e = 0; e < 4; ++e) { w0[e] = a0[e]; w0[4 + e] = a1[e]; w1[e] = b0[e]; w1[4 + e] = b1[e]; w2[e] = c0[e]; w2[4 + e] = c1[e]; } }
        float pm2[8], pm1[8], a[8], b[8];
        unpack8(ra[0], a); unpack8(rb[0], b);
#pragma unroll
        for (int e = 0; e < 8; ++e) pm2[e] = a[e] * b[e];
        unpack8(ra[1], a); unpack8(rb[1], b);
#pragma unroll
        for (int e = 0; e < 8; ++e) pm1[e] = a[e] * b[e];
#pragma unroll
        for (int r = 0; r < 8; ++r) {
            float p0[8], acc[8];
            unpack8(ra[r + 2], a); unpack8(rb[r + 2], b);
#pragma unroll
            for (int e = 0; e < 8; ++e) { p0[e] = a[e] * b[e]; acc[e] = w2[e] * p0[e] + w1[e] * pm1[e] + w0[e] * pm2[e]; }
            unpack8(rc[r], a); unpack8(rz[r], b);
            v4u w;
            w.x = pk2(a[0] * acc[0] * siluf_(b[0]), a[1] * acc[1] * siluf_(b[1])); w.y = pk2(a[2] * acc[2] * siluf_(b[2]), a[3] * acc[3] * siluf_(b[3]));
            w.z = pk2(a[4] * acc[4] * siluf_(b[4]), a[5] * acc[5] * siluf_(b[5])); w.w = pk2(a[6] * acc[6] * siluf_(b[6]), a[7] * acc[7] * siluf_(b[7]));
            *(v4u*)(mixed + (tokb + r) * DM + 512 + c8 * 8) = w;
#pragma unroll
            for (int e = 0; e < 8; ++e) { pm2[e] = pm1[e]; pm1[e] = p0[e]; }
        }
    }
}

__device__ __forceinline__ void ab_skinny(unsigned char* ws, const bf16* xb, const bf16* winT, LAS unsigned char* lds, int ci, int tid) {
    asm volatile("" : "+v"(tid));
    const int lane = tid & 63, wave = tid >> 6, gq = lane >> 4, ln = lane & 15;
    const bf16* ap = xb + (size_t)(ci * 64 + ln) * DM + 128 * wave + 8 * gq;
    const bf16* bp = winT + (size_t)(3328 + ln) * DM + 128 * wave + 8 * gq;
    const f32x4* pp = (const f32x4*)((const float*)(ws + WS_PART) + ((size_t)ci * 64 + (tid >> 3)) * 16);
    const f32x4 p0 = pp[0], p1 = pp[1], p2 = pp[2], p3 = pp[3];
    f32x4 acc[4];
#pragma unroll
    for (int mt = 0; mt < 4; ++mt) acc[mt] = (f32x4){0.f, 0.f, 0.f, 0.f};
    bf16x8 afr_[4][4], bfr_[4];
#pragma unroll
    for (int ks = 0; ks < 4; ++ks) {
        bfr_[ks] = *(const bf16x8*)(bp + 32 * ks);
#pragma unroll
        for (int mt = 0; mt < 4; ++mt) afr_[ks][mt] = *(const bf16x8*)(ap + (size_t)mt * 16 * DM + 32 * ks);
    }
    asm volatile("" ::: "memory"); __builtin_amdgcn_sched_barrier(0);
#pragma unroll
    for (int ks = 0; ks < 4; ++ks)
#pragma unroll
        for (int mt = 0; mt < 4; ++mt) acc[mt] = MFMA16(afr_[ks][mt], bfr_[ks], acc[mt]);
    __syncthreads();
    LAS f32x4* RED = (LAS f32x4*)lds;
#pragma unroll
    for (int mt = 0; mt < 4; ++mt) RED[(wave * 4 + mt) * 64 + lane] = acc[mt];
    __syncthreads();
    {
        const int token = tid >> 3, col = tid & 7, mt = token >> 4, row = token & 15, l2 = (row >> 2) * 16 + col, r = row & 3;
        float s = 0.f;
#pragma unroll
        for (int w = 0; w < 8; ++w) s += ((const LAS float*)(RED + (w * 4 + mt) * 64 + l2))[r];
        const size_t tok = (size_t)ci * 64 + token;
        const float ss = ((p0[0] + p0[1]) + (p0[2] + p0[3])) + ((p1[0] + p1[1]) + (p1[2] + p1[3])) + ((p2[0] + p2[1]) + (p2[2] + p2[3])) + ((p3[0] + p3[1]) + (p3[2] + p3[3]));
        ((float*)(ws + WS_AB))[tok * 8 + col] = s * rsqf_(ss * (1.0f / 1024.0f) + 1e-6f);
    }
}
constexpr int DL_GATES = 69632, DL_WT = 73728, DL_SS = 76800, DL_PS = 81920, DL_TP = 99328;
__device__ __forceinline__ v4u pack8s(const float (&y)[8], float s) { v4u w; w.x = pk2(y[0] * s, y[1] * s); w.y = pk2(y[2] * s, y[3] * s); w.z = pk2(y[4] * s, y[5] * s); w.w = pk2(y[6] * s, y[7] * s); return w; }
__device__ __forceinline__ void dl_raw_load(const bf16* proj, int b, int h, int n0, int k, int tid, v4u (&r)[4]) {
    const int n = n0 + k; const size_t tokb = (size_t)b * SEQ + n * 64;
#pragma unroll
    for (int q = 0; q < 4; ++q) {
        const int id = tid + 512 * q;
        r[q] = (v4u){0u, 0u, 0u, 0u};
        if (id < 1608) {
            const int m = id / 536, r2 = id - m * 536, rr = r2 >> 3, c8 = r2 & 7;
            if (n > 0 || rr >= 3) r[q] = *(const v4u*)(proj + (tokb + rr - 3) * PLD + C_DQ + m * 256 + h * 64 + c8 * 8);
        }
    }
}
__device__ __forceinline__ void dl_raw_write(LAS unsigned char* RAW, int buf, int tid, const v4u (&r)[4]) {
#pragma unroll
    for (int q = 0; q < 4; ++q) {
        const int id = tid + 512 * q;
        if (id < 1608) {
            const int m = id / 536, r2 = id - m * 536, rr = r2 >> 3, c8 = r2 & 7;
            *(LAS v4u*)(RAW + buf * 25728 + m * 8576 + rr * 128 + ((c8 ^ (rr & 7)) << 4)) = r[q];
        }
    }
}
__device__ __forceinline__ void dl_conv8l(const LAS unsigned char* R, const LAS float* WTm, int i, int cc, float (&y)[8]) {
    float x0[8], x1[8], x2[8], x3[8];
    { const int r = i + 3; unpack8(*(const LAS v4u*)(R + r * 128 + ((cc ^ (r & 7)) << 4)), x0); }
    { const int r = i + 2; unpack8(*(const LAS v4u*)(R + r * 128 + ((cc ^ (r & 7)) << 4)), x1); }
    { const int r = i + 1; unpack8(*(const LAS v4u*)(R + r * 128 + ((cc ^ (r & 7)) << 4)), x2); }
    { const int r = i;     unpack8(*(const LAS v4u*)(R + r * 128 + ((cc ^ (r & 7)) << 4)), x3); }
#pragma unroll
    for (int hh = 0; hh < 2; ++hh) {
        const f32x4 wa = *(const LAS f32x4*)(WTm + cc * 8 + hh * 4), wb = *(const LAS f32x4*)(WTm + 64 + cc * 8 + hh * 4),
                    wc = *(const LAS f32x4*)(WTm + 128 + cc * 8 + hh * 4), wd = *(const LAS f32x4*)(WTm + 192 + cc * 8 + hh * 4);
#pragma unroll
        for (int e = 0; e < 4; ++e) { const int ee = hh * 4 + e; y[ee] = siluf_(wa[e] * x3[ee] + wb[e] * x2[ee] + wc[e] * x1[ee] + wd[e] * x0[ee]); }
    }
}
__device__ __forceinline__ void dl_conv8r(const LAS unsigned char* R, const f32x4 (&w)[4][2], int i, int cc, float (&y)[8]) {
    float x0[8], x1[8], x2[8], x3[8];
    { const int r = i + 3; unpack8(*(const LAS v4u*)(R + r * 128 + ((cc ^ (r & 7)) << 4)), x0); }
    { const int r = i + 2; unpack8(*(const LAS v4u*)(R + r * 128 + ((cc ^ (r & 7)) << 4)), x1); }
    { const int r = i + 1; unpack8(*(const LAS v4u*)(R + r * 128 + ((cc ^ (r & 7)) << 4)), x2); }
    { const int r = i;     unpack8(*(const LAS v4u*)(R + r * 128 + ((cc ^ (r & 7)) << 4)), x3); }
#pragma unroll
    for (int hh = 0; hh < 2; ++hh)
#pragma unroll
        for (int e = 0; e < 4; ++e) { const int ee = hh * 4 + e; y[ee] = siluf_(w[0][hh][e] * x3[ee] + w[1][hh][e] * x2[ee] + w[2][hh][e] * x1[ee] + w[3][hh][e] * x0[ee]); }
}
__device__ __forceinline__ void dn_local4(int l, unsigned char* ws, LAS unsigned char* lds, int grp, int tid) {
    asm volatile("" : "+v"(tid));
    const int lane = tid & 63, wave = __builtin_amdgcn_readfirstlane(tid >> 6), gq = lane >> 4, ln = lane & 15;
    const int bh = grp >> 4, b = bh >> 2, h = bh & 3, n0 = (grp & 15) * 4;
    const bf16* proj = (const bf16*)(ws + WS_PROJ); const float* ab = (const float*)(ws + WS_AB);
    LAS float* GC = (LAS float*)(lds + DL_GATES); LAS float* BE = GC + 256; LAS float* EG = GC + 512; LAS float* EK = GC + 768;
    LAS float* WT = (LAS float*)(lds + DL_WT); LAS float* SS = (LAS float*)(lds + DL_SS);
    __syncthreads();
    if (wave < 4) {
        const int k = wave; const size_t row = (size_t)b * SEQ + (n0 + k) * 64 + lane;
        const float Adec = expf(inptr(I_ALOG)[l * 4 + h]), dtbias = inptr(I_DTB)[l * 4 + h];
        const float alpha = ab[row * 8 + h], betal = ab[row * 8 + 4 + h];
        float gc = -Adec * softplusf_(alpha + dtbias);
#pragma unroll
        for (int o = 1; o < 64; o <<= 1) { const float t = __builtin_bit_cast(float, __builtin_amdgcn_ds_bpermute((lane - o) << 2, __builtin_bit_cast(int, gc))); if (lane >= o) gc += t; }
        const float glast = __builtin_bit_cast(float, __builtin_amdgcn_readlane(__builtin_bit_cast(int, gc), 63));
        GC[k * 64 + lane] = gc; BE[k * 64 + lane] = sigmoidf_(betal); EG[k * 64 + lane] = expf(gc); EK[k * 64 + lane] = expf(glast - gc);
        if (lane == 0) ((float*)(ws + WS_CTL + CTL_EGL))[bh * 64 + n0 + k] = expf(glast);
    } else if (wave < 7) {
        const int m = wave - 4; const float* cw = inptr(I_DCW) + l * 3072 + m * 256 + h * 64;
#pragma unroll
        for (int tap = 0; tap < 4; ++tap) WT[m * 256 + tap * 64 + lane] = cw[tap * 768 + lane];
    }
    __syncthreads();
    {
        const int cc = wave, i = lane;
        LAS unsigned char* RAW = lds;
        v4u rawr[4];
        dl_raw_load(proj, b, h, n0, 0, tid, rawr); dl_raw_write(RAW, 0, tid, rawr);
        f32x4 wq_[4][2], wk_[4][2], wv_[4][2];
#pragma unroll
        for (int tp = 0; tp < 4; ++tp)
#pragma unroll
            for (int hh = 0; hh < 2; ++hh) { wq_[tp][hh] = *(const LAS f32x4*)(WT + tp * 64 + cc * 8 + hh * 4); wk_[tp][hh] = *(const LAS f32x4*)(WT + 256 + tp * 64 + cc * 8 + hh * 4); wv_[tp][hh] = *(const LAS f32x4*)(WT + 512 + tp * 64 + cc * 8 + hh * 4); }
#pragma unroll 1
        for (int k = 0; k < 4; ++k) {
            const int n = n0 + k, buf = k & 1;
            unsigned char* scr = ws + WS_SCR + (size_t)(bh * 64 + n) * 40960;
            bf16* gKN = (bf16*)scr; bf16* gQD = (bf16*)(scr + 8192); bf16* gQN = (bf16*)(scr + 16384); bf16* gBKT = (bf16*)(scr + 24576); bf16* gBVT = (bf16*)(scr + 32768);
            bf16* gKDT = (bf16*)(ws + WS_MISC + MISC_BT) + (size_t)(bh * 64 + n) * 4096;
            if (k == 0) { LDS_WAIT(); __syncthreads(); }
            if (k + 1 < 4) dl_raw_load(proj, b, h, n0, k + 1, tid, rawr);
            asm volatile("" ::: "memory");
            float yq[8], yk[8], yv[8];
            dl_conv8r(RAW + buf * 25728, wq_, i, cc, yq); dl_conv8r(RAW + buf * 25728 + 8576, wk_, i, cc, yk); dl_conv8r(RAW + buf * 25728 + 17152, wv_, i, cc, yv);
            float sq = 0.f, sk = 0.f;
#pragma unroll
            for (int e = 0; e < 8; ++e) { sq += yq[e] * yq[e]; sk += yk[e] * yk[e]; }
            LAS float* SSk = SS + (k & 1) * 1024;
            SSk[cc * 64 + i] = sq; SSk[512 + cc * 64 + i] = sk;
            if (k + 1 < 4) dl_raw_write(RAW, buf ^ 1, tid, rawr);
            LDS_WAIT(); __syncthreads();
            float tq = 0.f, tk = 0.f;
#pragma unroll
            for (int c2 = 0; c2 < 8; ++c2) { tq += SSk[c2 * 64 + i]; tk += SSk[512 + c2 * 64 + i]; }
            const float scq = 0.125f * rsqf_(tq + 1e-6f), sck = rsqf_(tk + 1e-6f);
            const float be = BE[k * 64 + i], eg = EG[k * 64 + i], ek = EK[k * 64 + i];
            *(v4u*)(gQN + i * 64 + cc * 8) = pack8s(yq, scq);
            *(v4u*)(gQD + i * 64 + cc * 8) = pack8s(yq, scq * eg);
            *(v4u*)(gKN + i * 64 + cc * 8) = pack8s(yk, sck);
            const float sb = sck * be * eg, sd = sck * ek;
            LAS unsigned short* TP = (LAS unsigned short*)(lds + DL_TP + wave * 3072);
#pragma unroll
            for (int e = 0; e < 8; ++e) {
                TP[e * 64 + i] = (unsigned short)f2bf(yk[e] * sb);
                TP[512 + e * 64 + i] = (unsigned short)f2bf(yk[e] * sd);
                TP[1024 + e * 64 + i] = (unsigned short)f2bf(yv[e] * be);
            }
            LDS_WAIT();
            *(v4u*)(gBKT + cc * 512 + i * 8) = *(const LAS v4u*)(TP + i * 8);
            *(v4u*)(gKDT + cc * 512 + i * 8) = *(const LAS v4u*)(TP + 512 + i * 8);
            *(v4u*)(gBVT + cc * 512 + i * 8) = *(const LAS v4u*)(TP + 1024 + i * 8);
        }
    }
    VM_WAIT(); __syncthreads();
    const int k = wave & 3, role = wave >> 2, n = n0 + k;
    unsigned char* scr = ws + WS_SCR + (size_t)(bh * 64 + n) * 40960;
    bf16* gW = (bf16*)scr; bf16* gATT = (bf16*)(scr + 16384); bf16* gMN = (bf16*)(scr + 24576); bf16* gUT = (bf16*)(scr + 32768);
    bf16* gBT = (bf16*)(ws + WS_MISC + MISC_BT) + (size_t)(bh * 64 + n) * 4096;
    LAS float* LM = (LAS float*)(lds + k * 17408); LAS float* TM = LM; LAS unsigned char* GS = lds + k * 17408;
    const LAS float* GCk = GC + k * 64; const LAS float* BEk = BE + k * 64;
    const int foff = (ln * 64 + 8 * gq);
    {
        bf16x8 fk[4][2], fq[4][2];
        const bf16* qsrc = role ? (const bf16*)gATT : (const bf16*)gW;
#pragma unroll
        for (int t = 0; t < 4; ++t)
#pragma unroll
            for (int ks = 0; ks < 2; ++ks) { fk[t][ks] = *(const bf16x8*)(gW + foff + t * 1024 + ks * 32); fq[t][ks] = *(const bf16x8*)(qsrc + foff + t * 1024 + ks * 32); }
        asm volatile("" ::: "memory"); __builtin_amdgcn_sched_barrier(0);
#pragma unroll
        for (int nt = 0; nt < 4; ++nt) {
            const int i = 16 * nt + ln; const float gci = GCk[i], bi = BEk[i];
#pragma unroll
            for (int mt = 0; mt < 4; ++mt) {
                if (mt <= nt) {
                    f32x4 a = (f32x4){0.f, 0.f, 0.f, 0.f};
#pragma unroll
                    for (int ks = 0; ks < 2; ++ks) a = MFMA16(fk[mt][ks], fq[nt][ks], a);
                    const f32x4 gcj = *(const LAS f32x4*)(GCk + 16 * mt + 4 * gq);
                    f32x4 o;
#pragma unroll
                    for (int r = 0; r < 4; ++r) { const int j = 16 * mt + 4 * gq + r; const float dec = (j <= i) ? __expf(gci - gcj[r]) : 0.f;
                        o[r] = role ? a[r] * dec : ((j < i) ? bi * a[r] * dec : 0.f); }
                    if (role) *(v2u*)(gATT + i * 64 + 16 * mt + 4 * gq) = pack4(o);
                    else *(LAS f32x4*)(LM + i * 68 + 16 * mt + 4 * gq) = o;
                } else if (role) {
                    unsigned zz; asm volatile("v_mov_b32 %0, 0" : "=v"(zz));
                    *(v2u*)(gATT + i * 64 + 16 * mt + 4 * gq) = (v2u){zz, zz};
                }
            }
        }
    }
    LDS_WAIT(); __syncthreads();
    if (role == 0) {
        __builtin_amdgcn_s_setprio(2);
        const int c = lane;
        LAS float* PS = (LAS float*)(lds + DL_PS + k * 4352);
#pragma unroll 1
        for (int bi = 0; bi < 4; ++bi) {
            float acc[16];
#pragma unroll
            for (int ii = 0; ii < 16; ++ii) acc[ii] = (16 * bi + ii == c) ? 1.f : 0.f;
            if (bi > 0) {
                f32x4 pc[4];
#pragma unroll
                for (int nt = 0; nt < 4; ++nt) pc[nt] = (f32x4){0.f, 0.f, 0.f, 0.f};
#pragma unroll 1
                for (int bj = 0; bj < bi; ++bj) {
#pragma unroll
                    for (int ks = 0; ks < 4; ++ks) {
                        const float a = LM[(16 * bi + ln) * 68 + 16 * bj + 4 * ks + gq];
#pragma unroll
                        for (int nt = 0; nt < 4; ++nt) { const float b2 = TM[(16 * bj + 4 * ks + gq) * 68 + 16 * nt + ln]; pc[nt] = __builtin_amdgcn_mfma_f32_16x16x4f32(a, b2, pc[nt], 0, 0, 0); }
                    }
                }
#pragma unroll
                for (int nt = 0; nt < 4; ++nt)
#pragma unroll
                    for (int r = 0; r < 4; ++r) PS[(4 * gq + r) * 68 + 16 * nt + ln] = pc[nt][r];
                LDS_WAIT();
#pragma unroll
                for (int ii = 0; ii < 16; ++ii) acc[ii] -= PS[ii * 68 + c];
            }
#pragma unroll
            for (int ii = 1; ii < 16; ++ii) {
                const LAS f32x4* lp = (const LAS f32x4*)(LM + (16 * bi + ii) * 68 + 16 * bi);
                float lrow[16];
#pragma unroll
                for (int q = 0; q < 4; ++q) { if (4 * q < ii) { const f32x4 t = lp[q]; lrow[4 * q] = t[0]; lrow[4 * q + 1] = t[1]; lrow[4 * q + 2] = t[2]; lrow[4 * q + 3] = t[3]; } }
                float s2 = 0.f;
#pragma unroll
                for (int jj = 0; jj + 1 < ii; ++jj) s2 += lrow[jj] * acc[jj];
                acc[ii] = (acc[ii] - s2) - lrow[ii - 1] * acc[ii - 1];
            }
            LDS_WAIT();
#pragma unroll
            for (int ii = 0; ii < 16; ++ii) TM[(16 * bi + ii) * 68 + c] = acc[ii];
            LDS_WAIT();
        }
        __builtin_amdgcn_s_setprio(0);
    } else {
        s5_xloc2(l, ws, grp, k, lane);
    }
    __syncthreads();
    bf16x8 fA_[4][2], fB_[4][2], fv[4][2], fb[4][2];
#pragma unroll
    for (int t = 0; t < 4; ++t)
#pragma unroll
        for (int ks = 0; ks < 2; ++ks) {
            fv[t][ks] = *(const bf16x8*)(gUT + foff + t * 1024 + ks * 32);
            fb[t][ks] = *(const bf16x8*)(gMN + foff + t * 1024 + ks * 32);
            if (role != 0) fA_[t][ks] = *(const bf16x8*)(gBT + foff + t * 1024 + ks * 32);
        }
    asm volatile("" ::: "memory"); __builtin_amdgcn_sched_barrier(0);
#pragma unroll
    for (int t = 0; t < 4; ++t)
#pragma unroll
        for (int ks = 0; ks < 2; ++ks) {
            if (role == 0) { const LAS f32x4* tp = (const LAS f32x4*)(TM + (16 * t + ln) * 68 + 32 * ks + 8 * gq); fA_[t][ks] = pack8(tp[0], tp[1]); fB_[t][ks] = fA_[t][ks]; }
            else {
                float tv[8];
#pragma unroll
                for (int e = 0; e < 8; ++e) tv[e] = TM[(32 * ks + 8 * gq + e) * 68 + 16 * t + ln];
                v4u w; w.x = pk2(tv[0], tv[1]); w.y = pk2(tv[2], tv[3]); w.z = pk2(tv[4], tv[5]); w.w = pk2(tv[6], tv[7]); fB_[t][ks] = __builtin_bit_cast(bf16x8, w); }
        }
    asm volatile("s_waitcnt vmcnt(0) lgkmcnt(0)" ::: "memory"); __syncthreads();
    if (role == 0) {
#pragma unroll
        for (int nt = 0; nt < 4; ++nt)
#pragma unroll
            for (int mt = 0; mt < 4; ++mt) {
                f32x4 au = (f32x4){0.f, 0.f, 0.f, 0.f}, aw = (f32x4){0.f, 0.f, 0.f, 0.f};
#pragma unroll
                for (int ks = 0; ks < 2; ++ks) { au = MFMA16(fA_[mt][ks], fv[nt][ks], au); aw = MFMA16(fb[nt][ks], fA_[mt][ks], aw); }
                *(v2u*)(gUT + (16 * nt + ln) * 64 + 16 * mt + 4 * gq) = pack4(au);
                *(v2u*)(gW + (16 * mt + ln) * 64 + 16 * nt + 4 * gq) = pack4(aw);
            }
    } else {
        f32x4 ag[4][4];
#pragma unroll
        for (int nt = 0; nt < 4; ++nt)
#pragma unroll
            for (int mt = 0; mt < 4; ++mt) {
                f32x4 a = (f32x4){0.f, 0.f, 0.f, 0.f};
#pragma unroll
                for (int ks = 0; ks < 2; ++ks) a = MFMA16(fA_[mt][ks], fB_[nt][ks], a);
                ag[mt][nt] = a;
            }
#pragma unroll
        for (int mt = 0; mt < 4; ++mt)
#pragma unroll
            for (int nt = 0; nt < 4; ++nt)
#pragma unroll
                for (int r = 0; r < 4; ++r) *(LAS unsigned short*)(GS + (16 * mt + 4 * gq + r) * 144 + (16 * nt + ln) * 2) = (unsigned short)f2bf(ag[mt][nt][r]);
        LDS_WAIT();
        bf16x8 fg[4][2];
#pragma unroll
        for (int t = 0; t < 4; ++t)
#pragma unroll
            for (int ks = 0; ks < 2; ++ks) fg[t][ks] = *(const LAS bf16x8*)(GS + (16 * t + ln) * 144 + (32 * ks + 8 * gq) * 2);
#pragma unroll
        for (int nt = 0; nt < 4; ++nt)
#pragma unroll
            for (int mt = 0; mt < 4; ++mt) {
                f32x4 ab2 = (f32x4){0.f, 0.f, 0.f, 0.f}, am = (f32x4){0.f, 0.f, 0.f, 0.f};
#pragma unroll
                for (int ks = 0; ks < 2; ++ks) { ab2 = MFMA16(fg[mt][ks], fv[nt][ks], ab2); am = MFMA16(fb[nt][ks], fg[mt][ks], am); }
                *(v2u*)(gBT + (16 * nt + ln) * 64 + 16 * gq + 4 * mt) = pack4(ab2);
                *(v2u*)(gMN + (16 * mt + ln) * 64 + 32 * (nt >> 1) + 8 * gq + 4 * (nt & 1)) = pack4(-am);
            }
    }
    LDS_WAIT();
}

__device__ __forceinline__ void dn_chain3(unsigned char* ws, LAS unsigned char* wl, int cidx, int lane) {
    const int bh = cidx >> 2, sv = cidx & 3;
    const int gq = lane >> 4, ln = lane & 15;
    f32x4 S[4];
#pragma unroll
    for (int t = 0; t < 4; ++t) S[t] = (f32x4){0.f, 0.f, 0.f, 0.f};
    const float eglv = ((const float*)(ws + WS_CTL + CTL_EGL))[bh * 64 + lane];
    const unsigned char* mbase = ws + WS_SCR + (size_t)(bh * 64) * 40960 + 24576 + (ln * 64 + 8 * gq) * 2;
    const unsigned char* bbase = ws + WS_MISC + MISC_BT + (size_t)(bh * 64) * 8192 + ((16 * sv + ln) * 64 + 16 * gq) * 2;
    unsigned char* spbase = ws + WS_MISC + MISC_SP + (size_t)(bh * 64) * 8192 + ((16 * sv + ln) * 64 + 4 * gq) * 2;
#pragma unroll
    for (int dt = 0; dt < 4; ++dt) *(v2u*)(spbase + dt * 32) = (v2u){0u, 0u};
    bf16x8 fM[4][4][2]; v4u fB[4][2];
#pragma unroll
    for (int j = 0; j < 4; ++j)
#pragma unroll
        for (int dt = 0; dt < 4; ++dt) {
#pragma unroll
            for (int ks = 0; ks < 2; ++ks) fM[j][dt][ks] = *(const bf16x8*)(mbase + (size_t)j * 40960 + dt * 2048 + ks * 64);
            if (dt < 2) fB[j][dt] = *(const v4u*)(bbase + (size_t)j * 8192 + dt * 16);
        }
#pragma unroll 1
    for (int n0 = 0; n0 < 64; n0 += 4) {
#pragma unroll
        for (int j = 0; j < 4; ++j) {
            const int n = n0 + j;
            const float eg = __builtin_bit_cast(float, __builtin_amdgcn_readlane(__builtin_bit_cast(int, eglv), n));
            bf16x8 sf[2];
            sf[0] = pack8(S[0], S[1]); sf[1] = pack8(S[2], S[3]);
            f32x4 Sn[4];
#pragma unroll
            for (int dt = 0; dt < 4; ++dt) {
                const v4u b4 = fB[j][dt >> 1]; const v2u bb = (dt & 1) ? (v2u){b4.z, b4.w} : (v2u){b4.x, b4.y};
                f32x4 a = S[dt] * eg + (f32x4){bflo(bb.x), bfhi(bb.x), bflo(bb.y), bfhi(bb.y)};
#pragma unroll
                for (int ks = 0; ks < 2; ++ks) a = MFMA16(fM[j][dt][ks], sf[ks], a);
                Sn[dt] = a;
            }
#pragma unroll
            for (int dt = 0; dt < 4; ++dt) S[dt] = Sn[dt];
            const int np = (n + 4 < 64) ? n + 4 : 63;
#pragma unroll
            for (int dt = 0; dt < 4; ++dt) {
#pragma unroll
                for (int ks = 0; ks < 2; ++ks) fM[j][dt][ks] = *(const bf16x8*)(mbase + (size_t)np * 40960 + dt * 2048 + ks * 64);
                if (dt < 2) fB[j][dt] = *(const v4u*)(bbase + (size_t)np * 8192 + dt * 16);
            }
            if (n + 1 < 64) {
#pragma unroll
                for (int dt = 0; dt < 4; ++dt) *(v2u*)(spbase + (size_t)(n + 1) * 8192 + dt * 32) = pack4(S[dt]);
            }
        }
    }
}

__device__ __forceinline__ void dn_out2(int l, unsigned char* ws, LAS unsigned char* VT, LAS float* SSX, volatile LAS unsigned* FL, int item, int k, int role, int lane) {
    asm volatile("" : "+v"(lane));
    const int b = item >> 8, h = (item >> 6) & 3, n = item & 63;
    const int gq = lane >> 4, ln = lane & 15;
    const bf16* proj = (const bf16*)(ws + WS_PROJ); bf16* mixed = (bf16*)(ws + WS_MIXED);
    const size_t tok0 = (size_t)b * SEQ + n * 64;
    const unsigned char* base = ws + WS_SCR + (size_t)item * 40960;
    const unsigned char* sp = ws + WS_MISC + MISC_SP + (size_t)item * 8192;
    const int foff = (ln * 64 + 8 * gq) * 2;
    bf16x8 fW[4][2], fQ[4][2], fA[4][2];
#pragma unroll
    for (int t = 0; t < 4; ++t)
#pragma unroll
        for (int ks = 0; ks < 2; ++ks) {
            fW[t][ks] = *(const bf16x8*)(base + foff + t * 2048 + ks * 64);
            fQ[t][ks] = *(const bf16x8*)(base + 8192 + foff + t * 2048 + ks * 64);
            fA[t][ks] = *(const bf16x8*)(base + 16384 + foff + t * 2048 + ks * 64);
        }
    bf16x8 sf[2][2]; v2u uu[2][4], zv[2][4]; f32x4 ng4[2];
#pragma unroll
    for (int s2 = 0; s2 < 2; ++s2) {
        const int sv = 2 * role + s2;
        ng4[s2] = *(const f32x4*)(inptr(I_DNG) + l * 64 + 16 * sv + 4 * gq);
#pragma unroll
        for (int ks = 0; ks < 2; ++ks) sf[s2][ks] = *(const bf16x8*)(sp + ((16 * sv + ln) * 64 + 32 * ks + 8 * gq) * 2);
#pragma unroll
        for (int mt = 0; mt < 4; ++mt) {
            uu[s2][mt] = *(const v2u*)(base + 32768 + ((16 * sv + ln) * 64 + 16 * mt + 4 * gq) * 2);
            zv[s2][mt] = *(const v2u*)(proj + (tok0 + 16 * mt + ln) * PLD + C_DZ + h * 64 + 16 * sv + 4 * gq);
        }
    }
    f32x4 o[2][4];
#pragma unroll
    for (int s2 = 0; s2 < 2; ++s2) {
#pragma unroll
        for (int mt = 0; mt < 4; ++mt) {
            f32x4 a = (f32x4){0.f, 0.f, 0.f, 0.f};
#pragma unroll
            for (int ks = 0; ks < 2; ++ks) a = MFMA16(fW[mt][ks], sf[s2][ks], a);
            const v2u u2 = uu[s2][mt];
            const f32x4 vn = (f32x4){bflo(u2.x) - a[0], bfhi(u2.x) - a[1], bflo(u2.y) - a[2], bfhi(u2.y) - a[3]};
            *(LAS v2u*)(VT + ln * 144 + (16 * mt + 4 * gq) * 2) = pack4(vn);
        }
        LDS_WAIT();
        bf16x8 vf[2];
#pragma unroll
        for (int ks = 0; ks < 2; ++ks) vf[ks] = *(const LAS bf16x8*)(VT + ln * 144 + (32 * ks + 8 * gq) * 2);
#pragma unroll
        for (int nt = 0; nt < 4; ++nt) {
            f32x4 a = (f32x4){0.f, 0.f, 0.f, 0.f};
#pragma unroll
            for (int ks = 0; ks < 2; ++ks) a = MFMA16(sf[s2][ks], fQ[nt][ks], a);
#pragma unroll
            for (int ks = 0; ks < 2; ++ks) a = MFMA16(vf[ks], fA[nt][ks], a);
            o[s2][nt] = a;
        }
        LDS_WAIT();
    }
    float ss[4];
#pragma unroll
    for (int nt = 0; nt < 4; ++nt) {
        float t = 0.f;
#pragma unroll
        for (int s2 = 0; s2 < 2; ++s2) t += (o[s2][nt][0] * o[s2][nt][0] + o[s2][nt][1] * o[s2][nt][1]) + (o[s2][nt][2] * o[s2][nt][2] + o[s2][nt][3] * o[s2][nt][3]);
        ss[nt] = t;
    }
#pragma unroll
    for (int nt = 0; nt < 4; ++nt) ss[nt] += __shfl_xor(ss[nt], 16);
#pragma unroll
    for (int nt = 0; nt < 4; ++nt) ss[nt] += __shfl_xor(ss[nt], 32);
    if (gq == 0) {
#pragma unroll
        for (int nt = 0; nt < 4; ++nt) SSX[((k * 2 + role) * 4 + nt) * 16 + ln] = ss[nt];
    }
    LDS_WAIT();
    FL[2 * k + role] = 1u;
    { unsigned sp_ = 0u; while (FL[2 * k + (role ^ 1)] == 0u && ++sp_ < (1u << 22)) __builtin_amdgcn_s_sleep(1); }
    asm volatile("" ::: "memory");
#pragma unroll
    for (int nt = 0; nt < 4; ++nt) {
        const float tot = ss[nt] + SSX[((k * 2 + (role ^ 1)) * 4 + nt) * 16 + ln];
        const float rs = rsqf_(tot * (1.f / 64.f) + 1e-6f);
        const size_t row = tok0 + 16 * nt + ln;
#pragma unroll
        for (int s2 = 0; s2 < 2; ++s2) {
            const int v0 = 16 * (2 * role + s2) + 4 * gq;
            const f32x4 g4 = ng4[s2];
            const v2u z = zv[s2][nt];
            f32x4 r;
            r[0] = o[s2][nt][0] * rs * g4[0] * siluf_(bflo(z.x)); r[1] = o[s2][nt][1] * rs * g4[1] * siluf_(bfhi(z.x));
            r[2] = o[s2][nt][2] * rs * g4[2] * siluf_(bflo(z.y)); r[3] = o[s2][nt][3] * rs * g4[3] * siluf_(bfhi(z.y));
            *(v2u*)(mixed + row * DM + 768 + h * 64 + v0) = pack4(r);
        }
    }
}
constexpr int PH_FINAL = 1 + 8 * DEPTH, PH_END = PH_FINAL + 1;
__global__ void __launch_bounds__(NWAVES * 64, 2) mk_kernel(Args args) {
    extern __shared__ __attribute__((aligned(16))) unsigned char lds_raw[];
    LAS unsigned char* lds = (LAS unsigned char*)lds_raw;
    volatile LAS unsigned* MISC = (volatile LAS unsigned*)(lds + MISC_OFF);
    const int tid = threadIdx.x, lane = tid & 63, wave = __builtin_amdgcn_readfirstlane(tid >> 6);
    const int G = gridDim.x; const int bx = blockIdx.x;
    const int vcu = (G % 8 == 0) ? (bx % 8) * (G / 8) + bx / 8 : bx;
    const int gw = vcu * NWAVES + wave, NGW = G * NWAVES;
    unsigned char* ws0 = args.ws;
    for (int u = tid; u < (LDS_BYTES - LDSCTL_OFF) / 4; u += NWAVES * 64) ((LAS unsigned*)(lds + LDSCTL_OFF))[u] = 0u;
    __syncthreads();
    const int lo = args.ph_lo, hi = args.ph_hi;
    XcdBarrier bar; bar.bar = (unsigned*)(ws0 + WS_CTL) + CW_BAR; bar.x = 0; bar.st = nullptr;
    if (hi - lo > 1) bar = xcd_barrier_post((unsigned*)(ws0 + WS_CTL) + CW_BAR, MISC + 8);
    bool need_bar = false;
#define IN(k) (lo <= (k) && (k) < hi)
#define PH_BEGIN(k) if (IN(k)) { if (need_bar) xcd_barrier(bar); need_bar = true;
#define PH_END_ }

    PH_BEGIN(0)
        for (int it = vcu; it < 256; it += G) s5_tables(ws0, lds, it, tid);
        __syncthreads();
        phase_prologue(args, ws0, lds, gw, NGW, wave, lane);
        if (hi - lo > 1 && tid < 64 && bar.st[0] == 0u) xcd_barrier_complete_wave(bar.bar, bar.x, bar.st);
        __syncthreads();
    PH_END_
#pragma nounroll
    for (int l_ = 0; l_ < DEPTH; ++l_) {
        int l = l_; asm volatile("" : "+s"(l));
        unsigned ones_ = ~0u; asm volatile("" : "+s"(ones_));
        int tid2 = wave * 64 + (int)__builtin_amdgcn_mbcnt_hi(ones_, __builtin_amdgcn_mbcnt_lo(ones_, 0u)); asm volatile("" : "+v"(tid2)); const int lane2 = tid2 & 63;
        GAS unsigned char* wsg_ = (GAS unsigned char*)ws0; asm volatile("" : "+s"(wsg_)); unsigned char* ws = (unsigned char*)wsg_;
        GAS float* outg_ = (GAS float*)args.out; asm volatile("" : "+s"(outg_)); float* outp = (float*)outg_;
        const bf16* proj = (const bf16*)(ws + WS_PROJ); bf16* mixed = (bf16*)(ws + WS_MIXED); const float* ab = (const float*)(ws + WS_AB);
        const int pb = 1 + 8 * l;
        PH_BEGIN(pb)
            {
            pg8::Gemm g{(const pg8::bf16_t*)outp, (const pg8::bf16_t*)(ws + WS_WIN + l * WIN_BYTES), MTOK, 3072, DM};
            pg8::StaticOrder S; S.init(MTOK, 3072, G, bx);
            pg8::EpiInProj E{(pg8::bf16_t*)(ws + WS_PROJ), (const float*)(ws + WS_PART), 0};
            pg8::gemm_phase<pg8::EpiInProj, pg8::StaticOrder, true, true>(lds, g, S, E, tid2);
            }
            for (int it = vcu; it < 256; it += G) ab_skinny(ws, (const bf16*)outp, (const bf16*)(ws + WS_WIN + l * WIN_BYTES), lds, it, tid2);
        PH_END_
        PH_BEGIN(pb + 1)
            { for (int it = vcu; it < 256; it += G) dn_local4(l, ws, lds, it, tid2); }
            __syncthreads();
        PH_END_
        PH_BEGIN(pb + 2)
            if (bx < 64) {
                if (wave == 0) dn_chain3(ws, lds, bx, lane2);
                else {
                    c_branch4(l, ws, bx, tid2 - 64, 448);
                    if (bx < 16 && wave <= 4) s5_scan(l, ws, bx * 256 + (tid2 - 64));
                }
            }
            else if (bx < 128) {
                pg8::Gemm g{(const pg8::bf16_t*)outp, (const pg8::bf16_t*)(ws + WS_WIN + l * WIN_BYTES) + (size_t)3072 * DM, MTOK, 256, DM};
                pg8::StaticOrder S; S.init(MTOK, 256, 64, bx - 64);
                pg8::EpiInProj E{(pg8::bf16_t*)(ws + WS_PROJ), (const float*)(ws + WS_PART), 3072};
                pg8::gemm_phase<pg8::EpiInProj, pg8::StaticOrder, true, true>(lds, g, S, E, tid2);
            }
            else {
                int bxl = bx; asm volatile("" : "+s"(bxl));
                for (int it = bxl - 128; it < 256; it += (G - 128)) a_branch(l, ws, lds, it, tid2);
            }
        PH_END_
        PH_BEGIN(pb + 3)
            {
                volatile LAS unsigned* FL = (volatile LAS unsigned*)(lds + 124928);
                if (lane2 == 0) FL[wave] = 0u;
                LDS_WAIT(); __syncthreads();
                const int dn_item = (wave >> 1) * G + vcu;
                if (wave < 4) {
                    dn_out2(l, ws, lds + 102400 + wave * 2304, (LAS float*)(lds + 122880), FL, dn_item, wave >> 1, wave & 1, lane2);
                    s5_groups(l, ws, lds, vcu, wave, lane2);
                } else {
                    s5_groups(l, ws, lds, vcu, wave, lane2);
                    dn_out2(l, ws, lds + 102400 + wave * 2304, (LAS float*)(lds + 122880), FL, dn_item, wave >> 1, wave & 1, lane2);
                }
                s5_glu(l, ws, lds, vcu, wave, lane2);
            }
        PH_END_
        PH_BEGIN(pb + 7)
            pg8::Gemm g{(const pg8::bf16_t*)(ws + WS_MIXED), (const pg8::bf16_t*)(ws + WS_WOUT + (size_t)l * 2 * MiB), MTOK, DM, DM};
            pg8::StaticOrder S; S.init(MTOK, DM, G, bx);
            pg8::EpiOutProj E{(pg8::bf16_t*)outp, (pg8::bf16_t*)(ws + WS_PROJ), (float*)(ws + WS_PART), l == DEPTH - 1};
            pg8::gemm_phase<pg8::EpiOutProj, pg8::StaticOrder, true, true>(lds, g, S, E, tid2);
        PH_END_
    }
    PH_BEGIN(PH_FINAL) { unsigned ones2_ = ~0u; asm volatile("" : "+s"(ones2_)); int tf = wave * 64 + (int)__builtin_amdgcn_mbcnt_hi(ones2_, __builtin_amdgcn_mbcnt_lo(ones2_, 0u)); asm volatile("" : "+v"(tf)); phase_final_norm(args, (const bf16*)(ws0 + WS_PROJ), vcu * NWAVES + (tf >> 6), NGW, tf & 63); } PH_END_
#undef IN
#undef PH_BEGIN
#undef PH_END_
}

extern "C" void kernel_launch(void* const* d_in, const int* in_sizes, int n_in, void* d_out, int out_size, void* d_ws, size_t ws_size, hipStream_t stream) {
    static int grid = 0;
    if (grid == 0) {
        if (n_in != 26 || in_sizes[0] != MTOK * DM || out_size != MTOK * DM || ws_size < WS_END) { fprintf(stderr, "kernel_launch: unexpected shapes (n_in %d, in0 %d, out %d, ws %zu)\n", n_in, n_in > 0 ? in_sizes[0] : -1, out_size, ws_size); grid = -1; return; }
        int dev = 0, cus = 0, per_cu = 0;
        if (hipGetDevice(&dev) != hipSuccess || hipDeviceGetAttribute(&cus, hipDeviceAttributeMultiprocessorCount, dev) != hipSuccess) { grid = -1; return; }
        if (hipFuncSetAttribute((const void*)mk_kernel, hipFuncAttributeMaxDynamicSharedMemorySize, LDS_BYTES) != hipSuccess) { fprintf(stderr, "kernel_launch: hipFuncSetAttribute failed\n"); grid = -1; return; }
        if (hipOccupancyMaxActiveBlocksPerMultiprocessor(&per_cu, (const void*)mk_kernel, NWAVES * 64, LDS_BYTES) != hipSuccess || per_cu < 1) { fprintf(stderr, "kernel_launch: occupancy query says %d blocks per CU\n", per_cu); (void)hipGetLastError(); grid = -1; return; }
        grid = cus;
        if (grid != 256) { fprintf(stderr, "kernel_launch: built for a 256-CU device (got %d)\n", grid); grid = -1; return; }
    }
    if (grid < 0) return;
    (void)hipMemsetAsync((char*)d_ws + WS_CTL, 0, CTL_ZERO_BYTES, stream);
    Args a{};
    for (int i = 0; i < 26; ++i) a.in[i] = (const float*)d_in[i];
    a.out = (float*)d_out; a.ws = (unsigned char*)d_ws;
    a.ph_lo = 0; a.ph_hi = PH_END;
    void* kargs[] = {(void*)&a};
    hipError_t e = hipLaunchCooperativeKernel((const void*)mk_kernel, dim3(grid), dim3(NWAVES * 64), kargs, LDS_BYTES, stream);
    if (e != hipSuccess) fprintf(stderr, "kernel_launch: cooperative launch failed: %s (grid %d)\n", hipGetErrorString(e), grid);
}
```
